# Optimizing an MI355X kernel written in HIP

```python
import math
import jax
import jax.numpy as jnp
from jax import lax
import numpy as np

D_MODEL = 4096
BATCH = 4
SEQ = 2048
DEPTH = 1

HEAD_DIM = 128
N_SB_HEADS = 16
N_DIL_HEADS = 16
SB_WIDTH = N_SB_HEADS * HEAD_DIM
DIL_WIDTH = N_DIL_HEADS * HEAD_DIM
MIX_WIDTH = SB_WIDTH + DIL_WIDTH
SPLIT_SIZES = (SB_WIDTH, SB_WIDTH, SB_WIDTH, SB_WIDTH, DIL_WIDTH, DIL_WIDTH, DIL_WIDTH, DIL_WIDTH)
IN_COLS = sum(SPLIT_SIZES)
SPLIT_POINTS = tuple(sum(SPLIT_SIZES[:i + 1]) for i in range(len(SPLIT_SIZES) - 1))
Q_BLOCK = 128
DIL_PAIRS = ((128, 1), (512, 4), (2048, 16))
ALIBI_MAX_BIAS = 8.0
EPS = 1e-6

kernel_name = 'hybrid_stickbreak_dilated_block'


def rmsnorm(x, g):
    xf = x.astype(jnp.float32)
    y = xf * lax.rsqrt(jnp.mean(xf * xf, axis=-1, keepdims=True) + EPS)
    return (y * g.astype(jnp.float32)).astype(x.dtype)


def split_heads(t, n_heads):
    b, s, _ = t.shape
    return t.reshape(b, s, n_heads, HEAD_DIM).transpose(0, 2, 1, 3)


def head_rmsnorm_merge(y, g):
    b, h, s, d = y.shape
    yf = y.astype(jnp.float32)
    yf = yf * lax.rsqrt(jnp.mean(yf * yf, axis=-1, keepdims=True) + EPS)
    return yf.transpose(0, 2, 1, 3).reshape(b, s, h * d) * g.astype(jnp.float32)


def alibi_slopes(n_heads):
    return jnp.exp2(-ALIBI_MAX_BIAS * jnp.arange(1, n_heads + 1, dtype=jnp.float32) / n_heads)


def stick_breaking_attention(q, k, v):
    b, h, s, d = q.shape
    nb = s // Q_BLOCK
    inv_sqrt_d = 1.0 / math.sqrt(d)
    kf = k.astype(jnp.float32)
    vf = v.astype(jnp.float32)
    qb = q.astype(jnp.float32).reshape(b, h, nb, Q_BLOCK, d).transpose(2, 0, 1, 3, 4)
    k_pos = jnp.arange(s)

    def one_block(args):
        qi, blk = args
        z = jnp.einsum('bhqd,bhkd->bhqk', qi, kf) * inv_sqrt_d
        q_pos = blk * Q_BLOCK + jnp.arange(Q_BLOCK)
        mask = k_pos[None, :] < q_pos[:, None]
        log_beta = jax.nn.log_sigmoid(z)
        log_one_minus = jnp.where(mask, jax.nn.log_sigmoid(-z), 0.0)
        suffix = lax.cumsum(log_one_minus, axis=3, reverse=True) - log_one_minus
        a = jnp.where(mask, jnp.exp(log_beta + suffix), 0.0)
        return jnp.einsum('bhqk,bhkd->bhqd', a, vf)

    out = lax.map(one_block, (qb, jnp.arange(nb)))
    return out.transpose(1, 2, 0, 3, 4).reshape(b, h, s, d)


def dilated_branch(q, k, v, slopes, window, dilation):
    b, h, s, d = q.shape
    n = window // dilation
    L = s // dilation
    Lp = -(-L // n) * n
    nb = Lp // n
    inv_sqrt_d = 1.0 / math.sqrt(d)

    def to_local(t):
        t = t.astype(jnp.float32).reshape(b, h, L, dilation, d).transpose(0, 1, 3, 2, 4)
        t = jnp.pad(t, ((0, 0), (0, 0), (0, 0), (0, Lp - L), (0, 0)))
        return t.reshape(b, h, dilation, nb, n, d)

    def with_prev(t):
        prev = jnp.pad(t, ((0, 0), (0, 0), (0, 0), (1, 0), (0, 0), (0, 0)))[:, :, :, :-1]
        return jnp.concatenate([prev, t], axis=4)

    ql = to_local(q)
    kw = with_prev(to_local(k))
    vw = with_prev(to_local(v))
    qi = jnp.arange(n)[:, None]
    ki = jnp.arange(2 * n)[None, :] - n
    steps = qi - ki
    blk = jnp.arange(nb)[:, None, None]
    valid = (steps >= 0)[None] & (steps <= n)[None] & ((blk * n + ki[None]) >= 0)
    dist = (steps * dilation).astype(jnp.float32)
    sc = jnp.einsum('bhrnqd,bhrnkd->bhrnqk', ql, kw) * inv_sqrt_d
    sc = sc - slopes[None, :, None, None, None, None] * dist
    sc = jnp.where(valid, sc, -jnp.inf)
    m = jnp.max(sc, axis=-1, keepdims=True)
    p = jnp.exp(sc - m)
    den = jnp.sum(p, axis=-1, keepdims=True)
    num = jnp.einsum('bhrnqk,bhrnkd->bhrnqd', p, vw)

    def from_local(t):
        x_dim = t.shape[-1]
        t = t.reshape(b, h, dilation, Lp, x_dim)[:, :, :, :L]
        return t.transpose(0, 1, 3, 2, 4).reshape(b, h, s, x_dim)

    return from_local(num), from_local(den), from_local(m)


def dilated_attention(q, k, v):
    slopes = alibi_slopes(q.shape[1])
    parts = [dilated_branch(q, k, v, slopes, w, r) for (w, r) in DIL_PAIRS]
    m_all = parts[0][2]
    for part in parts[1:]:
        m_all = jnp.maximum(m_all, part[2])
    num = sum(pn * jnp.exp(pm - m_all) for (pn, _, pm) in parts)
    den = sum(pd * jnp.exp(pm - m_all) for (_, pd, pm) in parts)
    return num / den


def setup_inputs(seed: int = 0) -> dict:
    key = jax.random.key(seed)
    ks = jax.random.split(key, 10)
    x = jax.random.normal(ks[0], (BATCH, SEQ, D_MODEL), jnp.float32)
    c = jax.random.normal(ks[1], (BATCH, D_MODEL), jnp.float32)
    w_ada = jax.random.normal(ks[2], (DEPTH, D_MODEL, 3 * D_MODEL), jnp.float32) * D_MODEL ** -0.5
    b_ada = 0.01 * jax.random.normal(ks[3], (DEPTH, 3 * D_MODEL), jnp.float32)
    g_norm = 1.0 + 0.1 * jax.random.normal(ks[4], (DEPTH, D_MODEL), jnp.float32)
    w_in = jax.random.normal(ks[5], (DEPTH, D_MODEL, IN_COLS), jnp.float32) * D_MODEL ** -0.5
    g_sb = 1.0 + 0.1 * jax.random.normal(ks[6], (DEPTH, SB_WIDTH), jnp.float32)
    g_dil = 1.0 + 0.1 * jax.random.normal(ks[7], (DEPTH, DIL_WIDTH), jnp.float32)
    w_out = jax.random.normal(ks[8], (DEPTH, MIX_WIDTH, D_MODEL), jnp.float32) * MIX_WIDTH ** -0.5
    g_final = 1.0 + 0.1 * jax.random.normal(ks[9], (D_MODEL,), jnp.float32)
    return {'x': x, 'c': c, 'w_ada': w_ada, 'b_ada': b_ada, 'g_norm': g_norm,
            'w_in': w_in, 'g_sb': g_sb, 'g_dil': g_dil, 'w_out': w_out, 'g_final': g_final}


def reference(x, c, w_ada, b_ada, g_norm, w_in, g_sb, g_dil, w_out, g_final):
    cs = jax.nn.silu(c.astype(jnp.float32))
    for layer in range(DEPTH):
        mod = cs @ w_ada[layer].astype(jnp.float32) + b_ada[layer].astype(jnp.float32)
        shift, scale, gate = jnp.split(mod, 3, axis=-1)
        h = rmsnorm(x, g_norm[layer]).astype(jnp.float32) * (1.0 + scale[:, None, :]) + shift[:, None, :]
        proj = jnp.einsum('bsd,de->bse', h.astype(x.dtype), w_in[layer])
        sb_q, sb_k, sb_v, sb_z, dl_q, dl_k, dl_v, dl_z = jnp.split(proj, SPLIT_POINTS, axis=-1)
        y_sb = stick_breaking_attention(split_heads(sb_q, N_SB_HEADS), split_heads(sb_k, N_SB_HEADS),
                                        split_heads(sb_v, N_SB_HEADS))
        y_sb = head_rmsnorm_merge(y_sb, g_sb[layer]) * jax.nn.silu(sb_z.astype(jnp.float32))
        y_dl = dilated_attention(split_heads(dl_q, N_DIL_HEADS), split_heads(dl_k, N_DIL_HEADS),
                                 split_heads(dl_v, N_DIL_HEADS))
        y_dl = head_rmsnorm_merge(y_dl, g_dil[layer]) * jax.nn.silu(dl_z.astype(jnp.float32))
        y = jnp.concatenate([y_sb, y_dl], axis=-1).astype(x.dtype)
        out = jnp.einsum('bse,ed->bsd', y, w_out[layer])
        x = x + (gate[:, None, :] * out.astype(jnp.float32)).astype(x.dtype)
    return rmsnorm(x, g_final)
```

```cpp
#include <hip/hip_runtime.h>
#include <hip/hip_cooperative_groups.h>
#include <cstdio>
#include <cstdint>
namespace cg = cooperative_groups;

#ifndef MK_N_LAUNCHES
#define MK_N_LAUNCHES 1
#endif
#ifndef REP_MASK
#define REP_MASK 0
#endif
#ifndef SB_EXIT_LOG2
#define SB_EXIT_LOG2 (-70.0f)
#endif
#ifndef FUSE_FINAL
#define FUSE_FINAL 1
#endif
#ifndef USE_CG_SYNC
#define USE_CG_SYNC 0
#endif
#ifndef SB_EARLY_EXIT
#define SB_EARLY_EXIT 1
#endif

namespace pg8 {
#define PG8_LAS __attribute__((address_space(3)))
typedef unsigned short bf16_t;
typedef short bf16x8 __attribute__((ext_vector_type(8)));
typedef float f32x4 __attribute__((ext_vector_type(4)));
typedef unsigned u32x4 __attribute__((ext_vector_type(4)));
constexpr int BM = 256, BK = 64, HALF = 128, HTB = HALF * BK * 2, STAGE_BYTES = 8 * HTB, NXCD = 8, WGM = 8;

__host__ __device__ __forceinline__ int lds_byte(int r, int c) { const int st = (r >> 4) * 2 + (c >> 5), rr = r & 15, cc = c & 31, ob = rr * 64 + cc * 2; return st * 1024 + (ob ^ (((ob >> 9) & 1) << 5)); }
__host__ __device__ __forceinline__ void stage_rc(int b, int& R, int& C) { const int st = b / 1024, sb = b % 1024, swz = sb ^ (((sb >> 9) & 1) << 5); R = (st >> 1) * 16 + swz / 64; C = (st & 1) * 32 + (swz % 64) / 2; }
__host__ __device__ __forceinline__ int perm32(int rho) { const int n = rho >> 4, i = rho & 15; return 8 * (i >> 2) + 4 * n + (i & 3); }

struct Unit { int pm, pn; };
struct Gemm { const bf16_t* A; const bf16_t* Bt; int M, N, K; };

struct StaticOrder {
    int nM, nN, nwg, G, c;
    __host__ __device__ void init(int M, int N, int G_, int c_) { nM = M / BM; nN = N / BM; nwg = nM * nN; G = G_; c = c_; }
    __host__ __device__ bool next(int i, Unit& u) const {
        const long L = (long)i * G + c; if (L >= nwg) return false;
        int wgid = (int)L; { const int q = nwg / NXCD, r = nwg % NXCD, xcd = wgid % NXCD, off = wgid / NXCD; wgid = (xcd < r ? xcd * (q + 1) : r * (q + 1) + (xcd - r) * q) + off; }
        const int nig = WGM * nN, gid = wgid / nig, fm = gid * WGM, gsz = (nM - fm) < WGM ? (nM - fm) : WGM;
        u.pm = fm + ((wgid % nig) % gsz); u.pn = (wgid % nig) / gsz; return true;
    }
    __device__ __forceinline__ void a_ready(const Unit&) const {}
    __device__ __forceinline__ void done(const Unit&) const {}
};

__device__ __forceinline__ unsigned cvt_pk_bf16(float lo, float hi) { unsigned r; asm volatile("v_cvt_pk_bf16_f32 %0, %1, %2" : "=v"(r) : "v"(lo), "v"(hi)); return r; }

struct EpiBf16 {
    static constexpr bool PERM = true, AFTER_DRAIN = false;
    bf16_t* O; size_t slab_stride;
    __device__ __forceinline__ void operator()(const f32x4 (&acc)[2][2][4][2], const Unit& u, int wr, int wc, int fr, int fq) const {
        const int colt = u.pn * BM, t = colt >> 11, h0 = (colt & 2047) >> 7, d = wc * 32 + 8 * fq;
        const int b = u.pm >> 3, s0 = (u.pm & 7) * BM + wr * 64 + fr;
        bf16_t* base = O + (size_t)t * slab_stride + ((size_t)(b * 16 + h0) * 2048 + s0) * 128 + d;
#pragma unroll
        for (int ai = 0; ai < 2; ++ai)
#pragma unroll
            for (int m = 0; m < 4; ++m) { bf16_t* rowp = base + (size_t)(ai * HALF + m * 16) * 128;
#pragma unroll
                for (int bj = 0; bj < 2; ++bj) { const f32x4 v0 = acc[ai][bj][m][0], v1 = acc[ai][bj][m][1];
                    u32x4 w; w.x = cvt_pk_bf16(v0[0], v0[1]); w.y = cvt_pk_bf16(v0[2], v0[3]); w.z = cvt_pk_bf16(v1[0], v1[1]); w.w = cvt_pk_bf16(v1[2], v1[3]);
                    *(u32x4*)(rowp + (size_t)bj * 2048 * 128) = w; } }
    }
};
struct EpiResGate {
    static constexpr bool PERM = true, AFTER_DRAIN = false;
    const float* x; float* out; const float* modacc; const float* b_ada; int ldc;
    __device__ __forceinline__ void operator()(const f32x4 (&acc)[2][2][4][2], const Unit& u, int wr, int wc, int fr, int fq) const {
        const int row0 = u.pm * BM + wr * 64 + fr, col0 = u.pn * BM + wc * 32 + 8 * fq, b = u.pm >> 3;
        f32x4 gv[2][2];
#pragma unroll
        for (int bj = 0; bj < 2; ++bj)
#pragma unroll
            for (int n = 0; n < 2; ++n) gv[bj][n] = *(const f32x4*)(modacc + (size_t)b * 12288 + 8192 + col0 + bj * HALF + 4 * n) + *(const f32x4*)(b_ada + 8192 + col0 + bj * HALF + 4 * n);
#pragma unroll
        for (int ai = 0; ai < 2; ++ai)
#pragma unroll
            for (int m = 0; m < 4; ++m) { const size_t off = (size_t)(row0 + ai * HALF + m * 16) * ldc + col0;
#pragma unroll
                for (int bj = 0; bj < 2; ++bj)
#pragma unroll
                    for (int n = 0; n < 2; ++n) { const f32x4 xv = *(const f32x4*)(x + off + bj * HALF + 4 * n);
                        *(f32x4*)(out + off + bj * HALF + 4 * n) = xv + gv[bj][n] * acc[ai][bj][m][n]; } }
    }
};

struct EpiFinal {
    static constexpr bool PERM = true, AFTER_DRAIN = false;
    const float* x; float* out; const float* modacc; const float* b_ada; const float* g_final; float* ss; unsigned* cnt; int ldc;
    __device__ __forceinline__ void operator()(f32x4 (&acc)[2][2][4][2], const Unit& u, int wr, int wc, int fr, int fq) const {
        const int row0 = u.pm * BM + wr * 64 + fr, col0 = u.pn * BM + wc * 32 + 8 * fq, b = u.pm >> 3;
        {
        f32x4 gv[2][2];
#pragma unroll
        for (int bj = 0; bj < 2; ++bj)
#pragma unroll
            for (int n = 0; n < 2; ++n) gv[bj][n] = *(const f32x4*)(modacc + (size_t)b * 12288 + 8192 + col0 + bj * HALF + 4 * n) + *(const f32x4*)(b_ada + 8192 + col0 + bj * HALF + 4 * n);
#pragma unroll
        for (int ai = 0; ai < 2; ++ai)
#pragma unroll
            for (int m = 0; m < 4; ++m) { const int row = row0 + ai * HALF + m * 16; const size_t off = (size_t)row * ldc + col0; float rs = 0.f;
#pragma unroll
                for (int bj = 0; bj < 2; ++bj)
#pragma unroll
                    for (int n = 0; n < 2; ++n) { const f32x4 xv = *(const f32x4*)(x + off + bj * HALF + 4 * n); const f32x4 v = xv + gv[bj][n] * acc[ai][bj][m][n];
                        acc[ai][bj][m][n] = v; rs += (v[0] * v[0] + v[1] * v[1]) + (v[2] * v[2] + v[3] * v[3]); }
                rs += __shfl_xor(rs, 16); rs += __shfl_xor(rs, 32);
                if (fq == 0) __hip_atomic_fetch_add(ss + row, rs, __ATOMIC_RELAXED, __HIP_MEMORY_SCOPE_AGENT); }
        }
        asm volatile("s_waitcnt vmcnt(0)" ::: "memory");
        unsigned* c = cnt + 64 * u.pm;
        if ((threadIdx.x & 63) == 0) __hip_atomic_fetch_add(c, 1u, __ATOMIC_RELAXED, __HIP_MEMORY_SCOPE_AGENT);
        { unsigned sp = 0; while (__hip_atomic_load(c, __ATOMIC_RELAXED, __HIP_MEMORY_SCOPE_AGENT) < 128u) { __builtin_amdgcn_s_sleep(2); if (++sp > (1u << 22)) break; } }
        __builtin_amdgcn_fence(__ATOMIC_ACQUIRE, "agent");
        f32x4 gf[2][2];
#pragma unroll
        for (int bj = 0; bj < 2; ++bj)
#pragma unroll
            for (int n = 0; n < 2; ++n) gf[bj][n] = *(const f32x4*)(g_final + col0 + bj * HALF + 4 * n);
#pragma unroll
        for (int ai = 0; ai < 2; ++ai)
#pragma unroll
            for (int m = 0; m < 4; ++m) { const int row = row0 + ai * HALF + m * 16; const size_t off = (size_t)row * ldc + col0;
                const float rstd = 1.0f / sqrtf(__hip_atomic_load(ss + row, __ATOMIC_RELAXED, __HIP_MEMORY_SCOPE_AGENT) * (1.0f / 4096.0f) + 1e-6f);
#pragma unroll
                for (int bj = 0; bj < 2; ++bj)
#pragma unroll
                    for (int n = 0; n < 2; ++n) *(f32x4*)(out + off + bj * HALF + 4 * n) = acc[ai][bj][m][n] * rstd * gf[bj][n]; }
    }
};
struct PanelOrder {
    int c;
    __device__ bool next(int i, Unit& u) const { if (i >= 2) return false; const int xcd = c & 7, off = c >> 3; u.pm = 4 * (xcd >> 1) + (off & 3) + 16 * i; u.pn = 8 * (xcd & 1) + (off >> 2); return true; }
    __device__ __forceinline__ void a_ready(const Unit&) const {}
    __device__ __forceinline__ void done(const Unit&) const {}
};

template <class Epi, class Sched, bool ALIGN_EPI = false, bool SP2 = false>
__device__ __forceinline__ void gemm_phase(PG8_LAS unsigned char* lds, const Gemm g, const Sched& S, const Epi& E) {
    const int tid = threadIdx.x, wid = __builtin_amdgcn_readfirstlane(tid >> 6), lane = tid & 63, wr = wid >> 2, wc = wid & 3, fr = lane & 15, fq = lane >> 4;
    const int K = g.K, nt = K / BK;
    unsigned voffA[2], voffB[2];
#pragma unroll
    for (int i = 0; i < 2; ++i) { int R, C; stage_rc(tid * 16 + i * 8192, R, C); const int Rb = Epi::PERM ? ((R & ~31) + perm32(R & 31)) : R;
        voffA[i] = (unsigned)(R * K + C) * 2u; voffB[i] = (unsigned)(Rb * K + C) * 2u; }
    const size_t kstep = (size_t)(BK * 2);
    const size_t hstep = (size_t)HALF * K * 2;
    const size_t tstep = 2 * hstep;
    const unsigned ldsw = (unsigned)wid * 1024u;
    const int aoff = lds_byte(wr * 64 + fr, fq * 8), boff = lds_byte(wc * 32 + fr, fq * 8);
#define PG8_SA(b, h) (((b) * 2 + (h)) * HTB)
#define PG8_SB(b, h) ((4 + (b) * 2 + (h)) * HTB)
#define PG8_STAGE(bufoff, gbase, voff) do { _Pragma("unroll") for (int _i = 0; _i < 2; ++_i) \
        __builtin_amdgcn_global_load_lds((const unsigned*)((const char*)(gbase) + (voff)[_i]), (PG8_LAS unsigned*)(lds + (bufoff) + ldsw + _i * 8192), 16, 0, 0); } while (0)
#define PG8_LDA(dst, b, h) do { _Pragma("unroll") for (int m = 0; m < 4; ++m) _Pragma("unroll") for (int k = 0; k < 2; ++k) dst[m][k] = *(const PG8_LAS bf16x8*)(lds + PG8_SA(b, h) + aoff + m * 2048 + k * 1024); } while (0)
#define PG8_LDB(dst, b, h) do { _Pragma("unroll") for (int n = 0; n < 2; ++n) _Pragma("unroll") for (int k = 0; k < 2; ++k) dst[n][k] = *(const PG8_LAS bf16x8*)(lds + PG8_SB(b, h) + boff + n * 2048 + k * 1024); } while (0)
#define PG8_MMA(ai, bj, At, Bt) do { __builtin_amdgcn_s_setprio(1); _Pragma("unroll") for (int m = 0; m < 4; ++m) _Pragma("unroll") for (int n = 0; n < 2; ++n) _Pragma("unroll") for (int k = 0; k < 2; ++k) \
        acc[ai][bj][m][n] = __builtin_amdgcn_mfma_f32_16x16x32_bf16(Bt[n][k], At[m][k], acc[ai][bj][m][n], 0, 0, 0); __builtin_amdgcn_s_setprio(0); } while (0)
#define PG8_WAIT_V(n) asm volatile("s_waitcnt vmcnt(" #n ")" ::: "memory")
#define PG8_WAIT_L(n) asm volatile("s_waitcnt lgkmcnt(" #n ")" ::: "memory")
#define PG8_BAR __builtin_amdgcn_s_barrier()
#define PG8_SCHED __builtin_amdgcn_sched_barrier(0)
    Unit cur, nxt; int ui = 0;
    if (!S.next(0, cur)) return;
    f32x4 acc[2][2][4][2];
#pragma unroll
    for (int a = 0; a < 2; ++a)
#pragma unroll
        for (int b = 0; b < 2; ++b)
#pragma unroll
            for (int m = 0; m < 4; ++m)
#pragma unroll
                for (int n = 0; n < 2; ++n) acc[a][b][m][n] = (f32x4){0.f, 0.f, 0.f, 0.f};
    bf16x8 At[4][2], B0[2][2], B1[2][2];
    const char* cA = (const char*)g.A + (size_t)cur.pm * tstep; const char* cB = (const char*)g.Bt + (size_t)cur.pn * tstep;
    S.a_ready(cur);
    if constexpr (SP2) {
        PG8_STAGE(PG8_SB(0, 0), cB, voffB); PG8_STAGE(PG8_SB(0, 1), cB + hstep, voffB); PG8_STAGE(PG8_SA(0, 0), cA, voffA); PG8_STAGE(PG8_SA(0, 1), cA + hstep, voffA);
        if (wr == 1) PG8_BAR;
        PG8_WAIT_V(2); PG8_BAR;
        PG8_STAGE(PG8_SB(1, 0), cB + kstep, voffB); PG8_STAGE(PG8_SA(1, 0), cA + kstep, voffA); PG8_STAGE(PG8_SB(1, 1), cB + hstep + kstep, voffB);
        PG8_WAIT_V(6); PG8_BAR;
    } else {
        PG8_STAGE(PG8_SB(0, 0), cB, voffB); PG8_STAGE(PG8_SA(0, 0), cA, voffA); PG8_STAGE(PG8_SB(0, 1), cB + hstep, voffB); PG8_STAGE(PG8_SA(0, 1), cA + hstep, voffA);
        if (wr == 1) PG8_BAR;
        PG8_WAIT_V(4); PG8_BAR;
        PG8_STAGE(PG8_SB(1, 0), cB + kstep, voffB); PG8_STAGE(PG8_SA(1, 0), cA + kstep, voffA); PG8_STAGE(PG8_SB(1, 1), cB + hstep + kstep, voffB);
        PG8_WAIT_V(6); PG8_BAR;
    }
    for (;;) {
        const bool has_next = S.next(ui + 1, nxt);
        const char* nA = has_next ? (const char*)g.A + (size_t)nxt.pm * tstep : cA; const char* nB = has_next ? (const char*)g.Bt + (size_t)nxt.pn * tstep : cB;
        for (int t = 0; t < nt; t += 2) {
            const bool last = (t == nt - 2);
            const char* a1 = cA + (size_t)(t + 1) * kstep;
            const char* a2 = last ? nA : cA + (size_t)(t + 2) * kstep; const char* b2 = last ? nB : cB + (size_t)(t + 2) * kstep;
            const char* a3 = a2 + kstep; const char* b3 = b2 + kstep;
            if (last && has_next) S.a_ready(nxt);
            if constexpr (SP2) {
            PG8_LDB(B0, 0, 0); PG8_LDB(B1, 0, 1); PG8_SCHED; PG8_LDA(At, 0, 0); PG8_STAGE(PG8_SA(1, 1), a1 + hstep, voffA);
            PG8_WAIT_V(8); PG8_WAIT_L(0); PG8_BAR; PG8_MMA(0, 0, At, B0); PG8_MMA(0, 1, At, B1); PG8_BAR; PG8_SCHED;
            PG8_LDA(At, 0, 1); PG8_STAGE(PG8_SB(0, 0), b2, voffB); PG8_STAGE(PG8_SB(0, 1), b2 + hstep, voffB); PG8_STAGE(PG8_SA(0, 0), a2, voffA);
            PG8_WAIT_V(8); PG8_WAIT_L(0); PG8_BAR; PG8_MMA(1, 0, At, B0); PG8_MMA(1, 1, At, B1); PG8_BAR; PG8_SCHED;
            PG8_LDB(B0, 1, 0); PG8_LDB(B1, 1, 1); PG8_SCHED; PG8_LDA(At, 1, 0); PG8_STAGE(PG8_SA(0, 1), a2 + hstep, voffA);
            PG8_WAIT_V(8); PG8_WAIT_L(0); PG8_BAR; PG8_MMA(0, 0, At, B0); PG8_MMA(0, 1, At, B1); PG8_BAR; PG8_SCHED;
            PG8_LDA(At, 1, 1); PG8_STAGE(PG8_SB(1, 0), b3, voffB); PG8_STAGE(PG8_SB(1, 1), b3 + hstep, voffB); PG8_STAGE(PG8_SA(1, 0), a3, voffA);
            PG8_WAIT_V(8); PG8_WAIT_L(0); PG8_BAR; PG8_MMA(1, 0, At, B0); PG8_MMA(1, 1, At, B1); PG8_BAR; PG8_SCHED;
            } else {
            PG8_LDB(B0, 0, 0); PG8_SCHED; PG8_LDA(At, 0, 0); PG8_STAGE(PG8_SA(1, 1), a1 + hstep, voffA);
            PG8_WAIT_L(8); PG8_BAR; PG8_WAIT_L(0); PG8_MMA(0, 0, At, B0); PG8_BAR; PG8_SCHED;
            PG8_LDB(B1, 0, 1); PG8_STAGE(PG8_SB(0, 0), b2, voffB);
            PG8_BAR; PG8_WAIT_L(0); PG8_MMA(0, 1, At, B1); PG8_BAR;
            PG8_LDA(At, 0, 1); PG8_STAGE(PG8_SA(0, 0), a2, voffA);
            PG8_BAR; PG8_WAIT_L(0); PG8_MMA(1, 0, At, B0); PG8_BAR; PG8_SCHED;
            PG8_STAGE(PG8_SB(0, 1), b2 + hstep, voffB);
            PG8_WAIT_V(6); PG8_BAR; PG8_MMA(1, 1, At, B1); PG8_BAR;
            PG8_LDB(B0, 1, 0); PG8_SCHED; PG8_LDA(At, 1, 0); PG8_STAGE(PG8_SA(0, 1), a2 + hstep, voffA);
            PG8_WAIT_L(8); PG8_BAR; PG8_WAIT_L(0); PG8_MMA(0, 0, At, B0); PG8_BAR; PG8_SCHED;
            PG8_LDB(B1, 1, 1); PG8_STAGE(PG8_SB(1, 0), b3, voffB);
            PG8_BAR; PG8_WAIT_L(0); PG8_MMA(0, 1, At, B1); PG8_BAR;
            PG8_LDA(At, 1, 1); PG8_STAGE(PG8_SA(1, 0), a3, voffA);
            PG8_BAR; PG8_WAIT_L(0); PG8_MMA(1, 0, At, B0); PG8_BAR; PG8_SCHED;
            PG8_STAGE(PG8_SB(1, 1), b3 + hstep, voffB);
            PG8_WAIT_V(6); PG8_BAR; PG8_MMA(1, 1, At, B1); PG8_BAR;
            }
        }
        if constexpr (ALIGN_EPI) { if (wr == 0) PG8_BAR; }
        if constexpr (!Epi::AFTER_DRAIN) { E(acc, cur, wr, wc, fr, fq); S.done(cur); }
        if (!has_next) break;
#pragma unroll
        for (int a = 0; a < 2; ++a)
#pragma unroll
            for (int b = 0; b < 2; ++b)
#pragma unroll
                for (int m = 0; m < 4; ++m)
#pragma unroll
                    for (int n = 0; n < 2; ++n) acc[a][b][m][n] = (f32x4){0.f, 0.f, 0.f, 0.f};
        cur = nxt; cA = nA; cB = nB; ++ui;
        if constexpr (ALIGN_EPI) { if (wr == 1) PG8_BAR; }
    }
    PG8_WAIT_V(0);
    if constexpr (!ALIGN_EPI) { if (wr == 0) PG8_BAR; }
    PG8_BAR;
#undef PG8_SA
#undef PG8_SB
#undef PG8_STAGE
#undef PG8_LDA
#undef PG8_LDB
#undef PG8_MMA
#undef PG8_WAIT_V
#undef PG8_WAIT_L
#undef PG8_BAR
#undef PG8_SCHED
}
}

#define LAS __attribute__((address_space(3)))
typedef unsigned short bf16;
typedef unsigned v4u __attribute__((ext_vector_type(4)));
typedef unsigned v2u __attribute__((ext_vector_type(2)));
typedef float f32x4 __attribute__((ext_vector_type(4)));
typedef float f32x16 __attribute__((ext_vector_type(16)));
typedef short bf16x8 __attribute__((ext_vector_type(8)));
typedef short s16x4 __attribute__((ext_vector_type(4)));

constexpr int NWAVES = 8, NTHREADS = NWAVES * 64;
constexpr int DM = 4096, BATCH = 4, SEQ = 2048, MTOK = BATCH * SEQ, HD = 128, NH = 16, GW = NH * HD  , INC = 8 * GW  , MIXW = 2 * GW;
constexpr float EPS = 1e-6f;
constexpr size_t MiB = 1u << 20;
constexpr size_t WS_CTL = 0, CTL_ZERO_BYTES = 1 * MiB;
constexpr size_t CTL_BAR_OFF = 16384;
constexpr size_t CTL_MOD_OFF = 65536;
constexpr size_t CTL_SS_OFF = 524288, CTL_PCNT_OFF = 589824;
constexpr size_t WS_WTIN = 2 * MiB, WS_WTOUT = 130 * MiB, WS_H = 162 * MiB, WS_PROJ = 226 * MiB, WS_Y = 482 * MiB, WS_OPART = 546 * MiB, WS_LPART = 642 * MiB, WS_END = 644 * MiB;
constexpr size_t PROJ_STRIDE = (size_t)MTOK * GW;
enum { T_SBQ = 0, T_SBK, T_SBV, T_SBZ, T_DLQ, T_DLK, T_DLV, T_DLZ };
constexpr int LDS_MISC_OFF = 131072;
constexpr int LDS_BYTES = 147456;

__device__ __forceinline__ unsigned f2bf(float f) { unsigned u = __builtin_bit_cast(unsigned, f); return (u + 0x7fffu + ((u >> 16) & 1u)) >> 16; }
__device__ __forceinline__ unsigned pk2(float lo, float hi) { return f2bf(lo) | (f2bf(hi) << 16); }
__device__ __forceinline__ float bf2f(unsigned short h) { return __builtin_bit_cast(float, (unsigned)h << 16); }
__device__ __forceinline__ float bflo(unsigned w) { return __builtin_bit_cast(float, w << 16); }
__device__ __forceinline__ float bfhi(unsigned w) { return __builtin_bit_cast(float, w & 0xffff0000u); }
__device__ __forceinline__ float wave_sum(float v) {
#pragma unroll
    for (int o = 1; o < 64; o <<= 1) v += __shfl_xor(v, o);
    return v;
}
__device__ __forceinline__ float silu_f(float z) { return z * __builtin_amdgcn_rcpf(1.0f + __builtin_amdgcn_exp2f(-1.4426950408889634f * z)); }
#define LDS_WAIT() asm volatile("s_waitcnt lgkmcnt(0)" ::: "memory")

__device__ __forceinline__ void p0_transpose_item(const float* W, int K, int N, bf16* WT, LAS float* scr, int item, int lane) {
    const int nblk = N / 32, kb = item / nblk, nb = item % nblk, k0 = 64 * kb, n0 = 32 * nb;
#pragma unroll 8
    for (int i = 0; i < 32; ++i) { const int kk = 2 * i + (lane >> 5); scr[kk * 33 + (lane & 31)] = __builtin_nontemporal_load(&W[(size_t)(k0 + kk) * N + n0 + (lane & 31)]); }
    LDS_WAIT(); asm volatile("" ::: "memory");
    const int c = lane & 7;
#pragma unroll
    for (int j = 0; j < 4; ++j) { const int n = (lane >> 3) + 8 * j; const LAS float* s = scr + (8 * c) * 33 + n;
        v4u o; o.x = pk2(s[0 * 33], s[1 * 33]); o.y = pk2(s[2 * 33], s[3 * 33]); o.z = pk2(s[4 * 33], s[5 * 33]); o.w = pk2(s[6 * 33], s[7 * 33]);
        *(v4u*)(WT + (size_t)(n0 + n) * K + k0 + 8 * c) = o; }
    LDS_WAIT(); asm volatile("" ::: "memory");
}
__device__ __forceinline__ void p0_mod_item(const float* c, const float* w_ada, float* modacc, LAS float* scr, int item, int lane) {
    const int nc = item % 48, kc = item / 48, n0 = nc * 256 + lane * 4, k0 = kc * 128;
#pragma unroll
    for (int i = 0; i < 8; ++i) { const int idx = i * 64 + lane, b = idx >> 7, k = idx & 127; scr[idx] = silu_f(c[b * DM + k0 + k]); }
    LDS_WAIT(); asm volatile("" ::: "memory");
    f32x4 a0 = {0.f, 0.f, 0.f, 0.f}, a1 = a0, a2 = a0, a3 = a0;
    const float* wp = w_ada + (size_t)k0 * 12288 + n0;
#pragma unroll 8
    for (int k = 0; k < 128; ++k) { const f32x4 w = __builtin_nontemporal_load((const f32x4*)(wp + (size_t)k * 12288));
        a0 += w * scr[k]; a1 += w * scr[128 + k]; a2 += w * scr[256 + k]; a3 += w * scr[384 + k]; }
#pragma unroll
    for (int j = 0; j < 4; ++j) {
        __hip_atomic_fetch_add(modacc + 0 * 12288 + n0 + j, a0[j], __ATOMIC_RELAXED, __HIP_MEMORY_SCOPE_AGENT);
        __hip_atomic_fetch_add(modacc + 1 * 12288 + n0 + j, a1[j], __ATOMIC_RELAXED, __HIP_MEMORY_SCOPE_AGENT);
        __hip_atomic_fetch_add(modacc + 2 * 12288 + n0 + j, a2[j], __ATOMIC_RELAXED, __HIP_MEMORY_SCOPE_AGENT);
        __hip_atomic_fetch_add(modacc + 3 * 12288 + n0 + j, a3[j], __ATOMIC_RELAXED, __HIP_MEMORY_SCOPE_AGENT); }
    LDS_WAIT(); asm volatile("" ::: "memory");
}
__device__ __forceinline__ void p1_row(const float* xrow, const float* g, const float* modb, const float* b_ada, bf16* orow, int lane) {
    const f32x4* xr = (const f32x4*)xrow + lane;
    float s = 0.f;
#pragma unroll 8
    for (int j = 0; j < 16; ++j) { const f32x4 v = xr[64 * j]; s += (v.x * v.x + v.y * v.y) + (v.z * v.z + v.w * v.w); }
    const float rstd = 1.0f / sqrtf(wave_sum(s) * (1.f / DM) + EPS);
    unsigned long long* o8 = (unsigned long long*)orow + lane;
    const float* gp = g + 4 * lane; const float* mp = modb + 4 * lane; const float* bp = b_ada + 4 * lane;
#pragma nounroll
    for (int jo = 0; jo < 16; jo += 4) {
        f32x4 v[4], gg[4], sh[4], sc[4];
#pragma unroll
        for (int ji = 0; ji < 4; ++ji) { const int j = jo + ji;
            v[ji] = xr[64 * j]; gg[ji] = *(const f32x4*)(gp + 256 * j);
            sh[ji] = *(const f32x4*)(mp + 256 * j) + *(const f32x4*)(bp + 256 * j); sc[ji] = *(const f32x4*)(mp + DM + 256 * j) + *(const f32x4*)(bp + DM + 256 * j) + 1.0f; }
#pragma unroll
        for (int ji = 0; ji < 4; ++ji) { const f32x4 h = v[ji] * rstd * gg[ji] * sc[ji] + sh[ji];
            o8[64 * (jo + ji)] = (unsigned long long)pk2(h.x, h.y) | ((unsigned long long)pk2(h.z, h.w) << 32); }
    }
}

constexpr float C2Q = 1.4426950408889634f * 0.08838834764831845f;
typedef __bf16 bf16x2_t __attribute__((ext_vector_type(2))); typedef float f32x2_t __attribute__((ext_vector_type(2)));
__device__ __forceinline__ unsigned cvtpk_s(float lo, float hi) { f32x2_t v = {lo, hi}; bf16x2_t b = __builtin_convertvector(v, bf16x2_t); return __builtin_bit_cast(unsigned, b); }
__device__ __forceinline__ int crow(int r, int hi) { return (r & 3) + 8 * (r >> 2) + 4 * hi; }
__device__ __forceinline__ void swap32(float x, float& lo, float& hi_) { auto rr = __builtin_amdgcn_permlane32_swap(__float_as_uint(x), __float_as_uint(x), false, false); lo = __uint_as_float(rr[0]); hi_ = __uint_as_float(rr[1]); }
typedef short v4i16_t __attribute__((ext_vector_type(4)));
__device__ __forceinline__ s16x4 vtr(LAS const unsigned char* p) { return __builtin_bit_cast(s16x4, __builtin_amdgcn_ds_read_tr16_b64_v4i16((LAS v4i16_t*)p)); }

__device__ __forceinline__ f32x16 qk_tile(const bf16x8 (&kf)[8], const bf16x8 (&qf)[8]) {
    f32x16 s0 = {}, s1 = {};
#pragma unroll
    for (int kk = 0; kk < 8; kk += 2) { s0 = __builtin_amdgcn_mfma_f32_32x32x16_bf16(kf[kk], qf[kk], s0, 0, 0, 0); s1 = __builtin_amdgcn_mfma_f32_32x32x16_bf16(kf[kk + 1], qf[kk + 1], s1, 0, 0, 0); }
    return s0 + s1;
}
__device__ __forceinline__ void pv_lane_offsets(unsigned (&tro)[4][2], int lane) {
    const int h = lane >> 5, blk = (lane >> 4) & 1, q4 = (lane & 15) >> 2, pp = lane & 3;
#pragma unroll
    for (int c = 0; c < 4; ++c)
#pragma unroll
        for (int t = 0; t < 2; ++t) { tro[c][t] = 256u * (unsigned)(8 * h + 4 * t + q4) + 16u * (unsigned)((4 * c + 2 * blk + (pp >> 1)) ^ ((q4 << 2) | (2 * h + t))) + 8u * (unsigned)(pp & 1);
            asm volatile("" : "+v"(tro[c][t])); }
}
__device__ __forceinline__ void pv_tile(f32x16 (&o)[4], const f32x16& p, LAS const unsigned char* vl, const unsigned (&tro)[4][2]) {
    const unsigned base = (unsigned)(uintptr_t)vl;
    unsigned pw[8];
#pragma unroll
    for (int i = 0; i < 8; ++i) pw[i] = cvtpk_s(p[2 * i], p[2 * i + 1]);
    unsigned ad[4][2];
#pragma unroll
    for (int c = 0; c < 4; ++c)
#pragma unroll
        for (int t = 0; t < 2; ++t) ad[c][t] = base + tro[c][t];
    s16x4 tr[2][4][2];
#pragma unroll
    for (int ks = 0; ks < 2; ++ks)
#pragma unroll
        for (int c = 0; c < 4; ++c)
#pragma unroll
            for (int t = 0; t < 2; ++t) asm volatile("ds_read_b64_tr_b16 %0, %1 offset:%2" : "=&v"(tr[ks][c][t]) : "v"(ad[c][t]), "i"(ks * 4096) : "memory");
    asm volatile("s_waitcnt lgkmcnt(0)" ::: "memory"); __builtin_amdgcn_sched_barrier(0);
#pragma unroll
    for (int ks = 0; ks < 2; ++ks) {
        const v4u pb = {pw[4 * ks], pw[4 * ks + 1], pw[4 * ks + 2], pw[4 * ks + 3]};
        const bf16x8 pf = __builtin_bit_cast(bf16x8, pb);
#pragma unroll
        for (int c = 0; c < 4; ++c) {
            const bf16x8 vf = {tr[ks][c][0][0], tr[ks][c][0][1], tr[ks][c][0][2], tr[ks][c][0][3], tr[ks][c][1][0], tr[ks][c][1][1], tr[ks][c][1][2], tr[ks][c][1][3]};
            o[c] = __builtin_amdgcn_mfma_f32_32x32x16_bf16(vf, pf, o[c], 0, 0, 0);
        }
    }
}

struct AttnP { const bf16* proj; bf16* Y; bf16* opart; float* lpart; const float* g_sb; };

constexpr int RING_D = 3, STAGE_B = 16384, RING_FLAGS_OFF = 2 * RING_D * STAGE_B;
#define ATT_BAR() asm volatile("s_waitcnt lgkmcnt(0)\n\ts_barrier" ::: "memory")
template <bool SB>
__device__ __forceinline__ void attn_unit(const AttnP& P, int p, int uid, LAS unsigned char* ring, int wave, int lane) {
    const int r32 = lane & 31, hi = lane >> 5, team = wave >> 2, qi = team ? 3 - (wave & 3) : (wave & 3);
    int r, q0, n, bh0, bh1, rho0, rho1;
    if (SB || p == 0) { const int bp = uid >> 4, k = uid & 15; r = 1; bh0 = 2 * bp; bh1 = bh0 + 1; rho0 = 0; rho1 = 0; q0 = 4 * k; n = SB ? 4 * k + 4 : (4 * k + 4 < 8 ? 4 * k + 4 : 8); }
    else if (p == 1) { const int bhh = uid >> 3, rp = (uid >> 2) & 1, k = uid & 3; r = 4; bh0 = bhh; bh1 = bhh; rho0 = 2 * rp; rho1 = rho0 + 1; q0 = 4 * k; n = 4 * k + 4 < 8 ? 4 * k + 4 : 8; }
    else { const int bhh = uid >> 3, pr = uid & 7; r = 16; bh0 = bhh; bh1 = bhh; rho0 = 2 * pr; rho1 = rho0 + 1; q0 = 0; n = 4; }
    const int bh = team ? bh1 : bh0, rho_w = team ? rho1 : rho0, b = bh >> 4, h = bh & 15, qblk_w = q0 + qi, top = q0 + 3;
    const size_t rs = (size_t)r * HD, hb = (size_t)bh * SEQ * HD;
    const size_t sb0 = (size_t)bh0 * SEQ * HD + (size_t)rho0 * HD, sb1 = (size_t)bh1 * SEQ * HD + (size_t)rho1 * HD;
    const bf16* Qs = P.proj + (SB ? T_SBQ : T_DLQ) * PROJ_STRIDE; const bf16* Ks = P.proj + (SB ? T_SBK : T_DLK) * PROJ_STRIDE; const bf16* Vs = P.proj + (SB ? T_SBV : T_DLV) * PROJ_STRIDE;
    bf16x8 qf[8];
    { const bf16* qp = Qs + hb + (size_t)rho_w * HD + (size_t)(32 * qblk_w + r32) * rs + 8 * hi;
#pragma unroll
      for (int kk = 0; kk < 8; ++kk) qf[kk] = *(const bf16x8*)(qp + 16 * kk); }
    const int q4 = lane >> 4, pc = lane & 15, krow = 4 * wave + q4, wp = (wave & 4) | ((wave & 1) << 1) | ((wave >> 1) & 1), vkey = 4 * wp + q4;
    const size_t koff = (size_t)krow * rs + (size_t)((pc ^ (krow & 15)) * 8), voff = (size_t)vkey * rs + (size_t)((pc ^ ((q4 << 2) | (wave & 3))) * 8);
#define ISSUE(j) do { const size_t tt_ = (size_t)(32 * (top - (j))) * rs; LAS unsigned char* st_ = ring + (((j) % RING_D) * 2) * STAGE_B + wave * 1024; \
        __builtin_amdgcn_global_load_lds((const unsigned*)(Ks + sb0 + tt_ + koff), (LAS unsigned*)st_, 16, 0, 0); \
        __builtin_amdgcn_global_load_lds((const unsigned*)(Vs + sb0 + tt_ + voff), (LAS unsigned*)(st_ + 8192), 16, 0, 0); \
        __builtin_amdgcn_global_load_lds((const unsigned*)(Ks + sb1 + tt_ + koff), (LAS unsigned*)(st_ + STAGE_B), 16, 0, 0); \
        __builtin_amdgcn_global_load_lds((const unsigned*)(Vs + sb1 + tt_ + voff), (LAS unsigned*)(st_ + STAGE_B + 8192), 16, 0, 0); } while (0)
    ISSUE(0); if (1 < n) ISSUE(1);
    f32x16 o[4]; o[0] = f32x16{}; o[1] = f32x16{}; o[2] = f32x16{}; o[3] = f32x16{};
    float carry = 0.f, m = -INFINITY, lsum = 0.f; bool done = false;
    const float slope2 = __builtin_amdgcn_exp2f(-0.5f * (float)(h + 1)) * 1.4426950408889634f * (float)r;
    float nb[16];
#pragma unroll
    for (int q = 0; q < 16; ++q) nb[q] = SB ? 0.f : -slope2 * (float)(r32 - crow(q, hi));
    LAS unsigned* flags = (LAS unsigned*)(ring + RING_FLAGS_OFF);
    unsigned tro[4][2]; pv_lane_offsets(tro, lane);
    unsigned kro[8];
#pragma unroll
    for (int kk = 0; kk < 8; ++kk) { kro[kk] = 256u * (unsigned)r32 + 16u * (unsigned)((2 * kk + hi) ^ (r32 & 15)); asm volatile("" : "+v"(kro[kk])); }
#pragma nounroll
    for (int j = 0; j < n; ++j) {
        if (j > 0 && j + 1 < n) asm volatile("s_waitcnt vmcnt(4)" ::: "memory"); else asm volatile("s_waitcnt vmcnt(0)" ::: "memory");
        ATT_BAR();
        if (SB && j > 0) { const v4u f0 = *(LAS v4u*)(flags + 8 * ((j - 1) & 1)), f1 = *(LAS v4u*)(flags + 8 * ((j - 1) & 1) + 4);
            if ((f0.x & f0.y & f0.z & f0.w & f1.x & f1.y & f1.z & f1.w) != 0u) break; }
        if (j + 2 < n) ISSUE(j + 2);
        const int tau = top - j, del = qblk_w - tau;
        if (del >= 0 && (SB ? !done : del <= 4)) {
            LAS const unsigned char* st = ring + ((j % RING_D) * 2 + team) * STAGE_B;
            bf16x8 kf[8];
#pragma unroll
            for (int kk = 0; kk < 8; ++kk) kf[kk] = *(LAS const bf16x8*)(st + kro[kk]);
            f32x16 s = qk_tile(kf, qf);
            if (SB) {
                float l[16];
#pragma unroll
                for (int q = 0; q < 16; ++q) { const float z2 = s[q] * C2Q, u = __builtin_amdgcn_logf(1.0f + __builtin_amdgcn_exp2f(-__builtin_fabsf(z2)));
                    l[q] = -(__builtin_fmaxf(z2, 0.f) + u); s[q] = z2 + l[q]; }
                if (del == 0) {
#pragma unroll
                    for (int q = 0; q < 16; ++q) if (!(crow(q, hi) < r32)) { l[q] = 0.f; s[q] = -INFINITY; }
                }
                float a[4], bb[4];
#pragma unroll
                for (int i = 0; i < 4; ++i) swap32((l[4 * i] + l[4 * i + 1]) + (l[4 * i + 2] + l[4 * i + 3]), a[i], bb[i]);
                float E[4]; E[3] = 0.f; E[2] = a[3] + bb[3]; E[1] = E[2] + (a[2] + bb[2]); E[0] = E[1] + (a[1] + bb[1]);
                const float tot = E[0] + (a[0] + bb[0]);
#pragma unroll
                for (int i = 0; i < 4; ++i) { const float T = carry + E[i] + (hi == 0 ? bb[i] : 0.f);
                    const float s3 = T, s2 = s3 + l[4 * i + 3], s1 = s2 + l[4 * i + 2], s0 = s1 + l[4 * i + 1];
                    s[4 * i + 3] = __builtin_amdgcn_exp2f(s[4 * i + 3] + s3); s[4 * i + 2] = __builtin_amdgcn_exp2f(s[4 * i + 2] + s2);
                    s[4 * i + 1] = __builtin_amdgcn_exp2f(s[4 * i + 1] + s1); s[4 * i + 0] = __builtin_amdgcn_exp2f(s[4 * i + 0] + s0); }
                carry += tot;
#if SB_EARLY_EXIT
                if (__all(carry < SB_EXIT_LOG2)) done = true;
#endif
            } else {
                const float t0 = slope2 * (float)(32 * del);
#pragma unroll
                for (int q = 0; q < 16; ++q) s[q] = __builtin_fmaf(s[q], C2Q, nb[q]) - t0;
                if (del == 0) {
#pragma unroll
                    for (int q = 0; q < 16; ++q) if (crow(q, hi) > r32) s[q] = -INFINITY;
                } else if (del == 4) {
#pragma unroll
                    for (int q = 0; q < 16; ++q) if (crow(q, hi) < r32) s[q] = -INFINITY;
                }
                float rm = __builtin_fmaxf(s[0], s[1]);
#pragma unroll
                for (int q = 2; q < 16; ++q) rm = __builtin_fmaxf(rm, s[q]);
                float r_lo, r_hi; swap32(rm, r_lo, r_hi);
                const float mn = __builtin_fmaxf(m, __builtin_fmaxf(r_lo, r_hi));
                float ps = 0.f;
#pragma unroll
                for (int q = 0; q < 16; ++q) { s[q] = __builtin_amdgcn_exp2f(s[q] - mn); ps += s[q]; }
                if (__all(mn == m)) lsum += ps;
                else { const float alpha = __builtin_amdgcn_exp2f(m - mn); lsum = lsum * alpha + ps; m = mn;
#pragma unroll
                    for (int c = 0; c < 4; ++c)
#pragma unroll
                        for (int q = 0; q < 16; ++q) o[c][q] *= alpha; }
            }
            pv_tile(o, s, st + 8192, tro);
        }
        if (SB) { const unsigned fa = (unsigned)(uintptr_t)(flags + 8 * (j & 1) + wave), fv = (done || tau == 0) ? 1u : 0u;
            asm volatile("ds_write_b32 %0, %1" :: "v"(fa), "v"(fv) : "memory"); }
    }
    asm volatile("s_waitcnt vmcnt(0) lgkmcnt(0)" ::: "memory");
#undef ISSUE
    const size_t tok = (size_t)b * SEQ + rho_w + (size_t)r * (32 * qblk_w + r32);
    if (SB) {
        float ss = 0.f;
#pragma unroll
        for (int c = 0; c < 4; ++c)
#pragma unroll
            for (int q = 0; q < 16; ++q) ss += o[c][q] * o[c][q];
        float s_lo, s_hi; swap32(ss, s_lo, s_hi);
        const float rstd = 1.0f / sqrtf((s_lo + s_hi) * (1.f / HD) + EPS);
        const bf16* Zs = P.proj + T_SBZ * PROJ_STRIDE + hb + (size_t)(32 * qblk_w + r32) * HD; bf16* Yr = P.Y + tok * MIXW + h * HD;
        v2u zw[16]; f32x4 gg[16];
#pragma unroll
        for (int c = 0; c < 4; ++c)
#pragma unroll
            for (int i = 0; i < 4; ++i) { const int d0 = 32 * c + 8 * i + 4 * hi; zw[4 * c + i] = *(const v2u*)(Zs + d0); gg[4 * c + i] = *(const f32x4*)(P.g_sb + h * HD + d0); }
#pragma unroll
        for (int c = 0; c < 4; ++c)
#pragma unroll
            for (int i = 0; i < 4; ++i) { const int d0 = 32 * c + 8 * i + 4 * hi; const v2u z = zw[4 * c + i]; const f32x4 g = gg[4 * c + i];
                const float y0 = o[c][4 * i] * rstd * g.x * silu_f(bflo(z.x)), y1 = o[c][4 * i + 1] * rstd * g.y * silu_f(bfhi(z.x));
                const float y2 = o[c][4 * i + 2] * rstd * g.z * silu_f(bflo(z.y)), y3 = o[c][4 * i + 3] * rstd * g.w * silu_f(bfhi(z.y));
                v2u w; w.x = cvtpk_s(y0, y1); w.y = cvtpk_s(y2, y3); *(v2u*)(Yr + d0) = w; }
    } else {
        float l_lo, l_hi; swap32(lsum, l_lo, l_hi);
        const float lt = l_lo + l_hi, inv = 1.0f / lt;
        bf16* Or = P.opart + (size_t)p * PROJ_STRIDE + tok * GW + h * HD;
#pragma unroll
        for (int c = 0; c < 4; ++c)
#pragma unroll
            for (int i = 0; i < 4; ++i) { const int d0 = 32 * c + 8 * i + 4 * hi;
                v2u w; w.x = cvtpk_s(o[c][4 * i] * inv, o[c][4 * i + 1] * inv); w.y = cvtpk_s(o[c][4 * i + 2] * inv, o[c][4 * i + 3] * inv); *(v2u*)(Or + d0) = w; }
        if (hi == 0) P.lpart[(size_t)p * (MTOK * NH) + tok * NH + h] = m + __builtin_amdgcn_logf(lt);
    }
    asm volatile("s_waitcnt vmcnt(0)" ::: "memory");
    ATT_BAR();
}


#define XB_TMO      128
#define XB_XCNT(j)  (256  + 64 * (j))
#define XB_XSUB(j)  (1280 + 64 * (j))
#define XB_XGEN(j)  (2304 + 64 * (j))
#define XB_TOP      3328
#define XB_TOPGEN   3392
#define XCD_BAR_WORDS 3456
#define XB_SPIN_CAP (1u << 18)
__device__ __forceinline__ unsigned xb_ld(unsigned* p)              { return __hip_atomic_load(p, __ATOMIC_RELAXED, __HIP_MEMORY_SCOPE_AGENT); }
__device__ __forceinline__ unsigned xb_add(unsigned* p, unsigned v) { return __hip_atomic_fetch_add(p, v, __ATOMIC_RELAXED, __HIP_MEMORY_SCOPE_AGENT); }
__device__ __forceinline__ unsigned xb_xcc_id() { return (unsigned)__builtin_amdgcn_s_getreg((3 << 11) | 20) & 0xFu; }
#define XB_SPIN(cond, bar) do { unsigned _sp = 0; while (cond) { __builtin_amdgcn_s_sleep(1); \
    if ((++_sp & 255u) == 0u) { if (xb_ld(&(bar)[XB_TMO])) break; if (_sp > XB_SPIN_CAP) { atomicAdd(&(bar)[XB_TMO], 1u); break; } } } } while (0)
struct XcdBarrier { unsigned* bar; unsigned x; volatile LAS unsigned* st; };
__device__ __forceinline__ XcdBarrier xcd_barrier_post(unsigned* bar, volatile LAS unsigned* st) {
    XcdBarrier b; b.bar = bar; b.x = xb_xcc_id(); b.st = st;
    if (threadIdx.x == 0) (void)xb_add(&bar[XB_XCNT(b.x)], 1u);
    return b;
}
__device__ __forceinline__ void xcd_barrier_complete(unsigned* bar, unsigned x, unsigned& nloc, unsigned& nx) {
    const unsigned G = gridDim.x * gridDim.y * gridDim.z;
    unsigned sum, cnt, mine, sp = 0u;
    for (;;) {
        sum = 0u; cnt = 0u; mine = 0u;
#pragma unroll
        for (unsigned j = 0; j < 16; ++j) { const unsigned c = xb_ld(&bar[XB_XCNT(j)]); sum += c; cnt += (c > 0u) ? 1u : 0u; mine = (j == x) ? c : mine; }
        if (sum == G) break;
        __builtin_amdgcn_s_sleep(1);
        if ((++sp & 255u) == 0u) { if (xb_ld(&bar[XB_TMO])) break; if (sp > XB_SPIN_CAP) { atomicAdd(&bar[XB_TMO], 1u); break; } }
    }
    nloc = mine > 0u ? mine : 1u; nx = cnt > 0u ? cnt : 1u;
}
__device__ __forceinline__ void xcd_barrier(const XcdBarrier& b) {
    asm volatile("s_waitcnt vmcnt(0)" ::: "memory");
    __syncthreads();
    if (threadIdx.x == 0) {
        unsigned* bar = b.bar;
        __builtin_amdgcn_s_waitcnt(0);
        unsigned nloc = b.st[0], nx = b.st[1];
        if (nloc == 0u) { xcd_barrier_complete(bar, b.x, nloc, nx); b.st[0] = nloc; b.st[1] = nx; }
        const unsigned old = xb_add(&bar[XB_XSUB(b.x)], 1u);
        const unsigned gen = old / nloc;
        if (old + 1u == (gen + 1u) * nloc) {
            __builtin_amdgcn_fence(__ATOMIC_RELEASE, "agent");
            asm volatile("s_waitcnt vmcnt(0)" ::: "memory");
            const unsigned og = xb_add(&bar[XB_TOP], 1u);
            const unsigned tg = og / nx;
            if (og + 1u == (tg + 1u) * nx) xb_add(&bar[XB_TOPGEN], 1u);
            else XB_SPIN(xb_ld(&bar[XB_TOPGEN]) == tg, bar);
            __builtin_amdgcn_fence(__ATOMIC_ACQUIRE, "agent");
            xb_add(&bar[XB_XGEN(b.x)], 1u);
            asm volatile("s_waitcnt vmcnt(0)" ::: "memory");
        } else {
            XB_SPIN(xb_ld(&bar[XB_XGEN(b.x)]) == gen, bar);
            __builtin_amdgcn_fence(__ATOMIC_ACQUIRE, "agent");
            asm volatile("s_waitcnt vmcnt(0)" ::: "memory");
        }
    }
    __syncthreads();
}

struct Args { const float* x; const float* c; const float* w_ada; const float* b_ada; const float* g_norm; const float* w_in; const float* g_sb; const float* g_dil; const float* w_out; const float* g_final;
              float* out; unsigned char* ws; int ph_lo, ph_hi; };

__global__ void __launch_bounds__(NTHREADS) hybrid_fwd(Args args) {
    extern __shared__ __attribute__((aligned(16))) unsigned char lds_raw[];
    LAS unsigned char* lds = (LAS unsigned char*)lds_raw;
    const int tid = threadIdx.x, lane = tid & 63, wave = __builtin_amdgcn_readfirstlane(tid >> 6);
    const int G = gridDim.x, gw = blockIdx.x * NWAVES + wave, NGW = G * NWAVES;
    const int vcu = (G % 8 == 0) ? ((int)blockIdx.x % 8) * (G / 8) + (int)blockIdx.x / 8 : (int)blockIdx.x, vgw = vcu * NWAVES + wave;
    unsigned char* ws = args.ws;
    unsigned* ctl = (unsigned*)(ws + WS_CTL);
    float* modacc = (float*)(ws + WS_CTL + CTL_MOD_OFF);
    bf16* WtIn = (bf16*)(ws + WS_WTIN); bf16* WtOut = (bf16*)(ws + WS_WTOUT); bf16* Hb = (bf16*)(ws + WS_H); bf16* Proj = (bf16*)(ws + WS_PROJ);
    bf16* Yb = (bf16*)(ws + WS_Y); bf16* Opart = (bf16*)(ws + WS_OPART); float* Lpart = (float*)(ws + WS_LPART);
    const int lo = args.ph_lo, hi = args.ph_hi;
#ifndef PH_MASK
#define PH_MASK 0x7f
#endif
#define IN(k) (((PH_MASK >> (k)) & 1) && lo <= (k) && (k) < hi)
#if USE_CG_SYNC
#define SEAM(k) do { if (IN(k) && IN((k) + 1)) cg::this_grid().sync(); } while (0)
#define SEAM_ALWAYS() cg::this_grid().sync()
#else
    if (lo < 0) cg::this_grid().sync();
    volatile LAS unsigned* MISC = (volatile LAS unsigned*)(lds + LDS_MISC_OFF);
    if (tid < 16) MISC[tid] = 0u;
    __syncthreads();
    const XcdBarrier xbar = xcd_barrier_post(ctl + CTL_BAR_OFF / 4, MISC + 8);
#define SEAM(k) do { if (IN(k) && IN((k) + 1)) xcd_barrier(xbar); } while (0)
#define SEAM_ALWAYS() xcd_barrier(xbar)
#endif

    if (REP_MASK & 128) { for (int i = 0; i < 10; ++i) SEAM_ALWAYS(); }
    if (IN(0)) {
        LAS float* scr = (LAS float*)(lds + wave * 16384);
        constexpr int I_IN = (DM / 64) * (INC / 32), I_OUT = (MIXW / 64) * (DM / 32), I_MOD = (DM / 128) * 48;
        if (REP_MASK & 1) for (int it = gw; it < I_IN + I_OUT; it += NGW) { if (it < I_IN) p0_transpose_item(args.w_in, DM, INC, WtIn, scr, it, lane); else p0_transpose_item(args.w_out, MIXW, DM, WtOut, scr, it - I_IN, lane); }
        unsigned* modcnt = ctl + 128;
        for (int it = gw; it < I_MOD + I_IN + I_OUT; it += NGW) {
            int r = it;
            if (r < I_MOD) { p0_mod_item(args.c, args.w_ada, modacc, scr, r, lane);
                if (REP_MASK & 256) p0_mod_item(args.c, args.w_ada, modacc + 4 * 12288, scr, r, lane);
                asm volatile("s_waitcnt vmcnt(0)" ::: "memory");
                if (lane == 0) __hip_atomic_fetch_add(modcnt, 1u, __ATOMIC_RELAXED, __HIP_MEMORY_SCOPE_AGENT);
                continue; } r -= I_MOD;
            if (r < I_IN) { p0_transpose_item(args.w_in, DM, INC, WtIn, scr, r, lane); continue; } r -= I_IN;
            p0_transpose_item(args.w_out, MIXW, DM, WtOut, scr, r, lane);
        }
        if (IN(1)) { unsigned sp = 0; while (__hip_atomic_load(modcnt, __ATOMIC_RELAXED, __HIP_MEMORY_SCOPE_AGENT) < (unsigned)I_MOD) { __builtin_amdgcn_s_sleep(2); if (++sp > (1u << 22)) break; }
            __builtin_amdgcn_fence(__ATOMIC_ACQUIRE, "agent"); }
    }
    if (!(IN(0) && IN(1))) SEAM(0);
    if (IN(1)) {
#pragma nounroll
        for (int m = gw; m < MTOK; m += NGW) p1_row(args.x + (size_t)m * DM, args.g_norm, modacc + (size_t)(m >> 11) * 12288, args.b_ada, Hb + (size_t)m * DM, lane);
    }
    SEAM(1);
    if (IN(2)) {
        pg8::Gemm g{Hb, WtIn, MTOK, INC, DM}; pg8::StaticOrder S; S.init(MTOK, INC, G, (int)blockIdx.x);
        pg8::EpiBf16 E{Proj, PROJ_STRIDE};
        pg8::gemm_phase<pg8::EpiBf16, pg8::StaticOrder, true, true>(lds, g, S, E);
        if (REP_MASK & 4) pg8::gemm_phase<pg8::EpiBf16, pg8::StaticOrder, true, true>(lds, g, S, E);
    }
    SEAM(2);
    if (IN(3)) {
        const AttnP P{Proj, Yb, Opart, Lpart, args.g_sb};
        for (int rep = 0; rep < ((REP_MASK & (8 | 512 | 1024)) ? 2 : 1); ++rep)
        for (int u = vcu, rnd = 0; u < 2048; u += G, ++rnd) {
            const int kind = u >> 9; int uid = u & 511;
            if (rnd & 1) uid ^= (kind <= 1) ? 15 : (kind == 2) ? 3 : 0;
            if (rep == 1 && (REP_MASK & 512) && kind != 0) continue;
            if (rep == 1 && (REP_MASK & 1024) && kind == 0) continue;
            if (kind == 0) attn_unit<true>(P, 0, uid, lds, wave, lane);
            else attn_unit<false>(P, kind - 1, uid, lds, wave, lane);
        }
    }
    SEAM(3);
    if (IN(4)) {
        const bf16* Zs = Proj + T_DLZ * PROJ_STRIDE;
        const int hcol = tid & 255, h = hcol >> 4, col = hcol * 8;
        const f32x4 g0 = *(const f32x4*)(args.g_dil + col), g1 = *(const f32x4*)(args.g_dil + col + 4);
        const size_t tstep = (size_t)2 * G;
#pragma nounroll
        for (size_t tok0 = (size_t)blockIdx.x * 2 + (tid >> 8); tok0 < (size_t)MTOK; tok0 += 4 * tstep) {
            float L[4][3]; v4u o0[4], o1[4], o2[4], zw[4];
#pragma unroll
            for (int k = 0; k < 4; ++k) { const size_t tok = tok0 + k * tstep; const bool ok = tok < (size_t)MTOK; const size_t tk = ok ? tok : tok0;
                L[k][0] = Lpart[tk * NH + h]; L[k][1] = Lpart[(size_t)MTOK * NH + tk * NH + h]; L[k][2] = Lpart[(size_t)2 * MTOK * NH + tk * NH + h];
                o0[k] = *(const v4u*)(Opart + tk * GW + col); o1[k] = *(const v4u*)(Opart + PROJ_STRIDE + tk * GW + col); o2[k] = *(const v4u*)(Opart + 2 * PROJ_STRIDE + tk * GW + col);
                zw[k] = *(const v4u*)(Zs + (((tk >> 11) * NH + h) * SEQ + (tk & 2047)) * HD + (col & 127)); }
#pragma unroll
            for (int k = 0; k < 4; ++k) { const size_t tok = tok0 + k * tstep;
                const float mx = __builtin_fmaxf(L[k][0], __builtin_fmaxf(L[k][1], L[k][2]));
                float w0 = __builtin_amdgcn_exp2f(L[k][0] - mx), w1 = __builtin_amdgcn_exp2f(L[k][1] - mx), w2 = __builtin_amdgcn_exp2f(L[k][2] - mx);
                const float inv = 1.0f / (w0 + w1 + w2); w0 *= inv; w1 *= inv; w2 *= inv;
                float y[8]; float ss = 0.f;
#pragma unroll
                for (int e = 0; e < 4; ++e) { y[2 * e] = w0 * bflo(o0[k][e]) + w1 * bflo(o1[k][e]) + w2 * bflo(o2[k][e]); y[2 * e + 1] = w0 * bfhi(o0[k][e]) + w1 * bfhi(o1[k][e]) + w2 * bfhi(o2[k][e]);
                    ss += y[2 * e] * y[2 * e] + y[2 * e + 1] * y[2 * e + 1]; }
                ss += __shfl_xor(ss, 1); ss += __shfl_xor(ss, 2); ss += __shfl_xor(ss, 4); ss += __shfl_xor(ss, 8);
                const float rstd = 1.0f / sqrtf(ss * (1.f / HD) + EPS);
                v4u w;
                w.x = cvtpk_s(y[0] * rstd * g0.x * silu_f(bflo(zw[k].x)), y[1] * rstd * g0.y * silu_f(bfhi(zw[k].x)));
                w.y = cvtpk_s(y[2] * rstd * g0.z * silu_f(bflo(zw[k].y)), y[3] * rstd * g0.w * silu_f(bfhi(zw[k].y)));
                w.z = cvtpk_s(y[4] * rstd * g1.x * silu_f(bflo(zw[k].z)), y[5] * rstd * g1.y * silu_f(bfhi(zw[k].z)));
                w.w = cvtpk_s(y[6] * rstd * g1.z * silu_f(bflo(zw[k].w)), y[7] * rstd * g1.w * silu_f(bfhi(zw[k].w)));
                if (tok < (size_t)MTOK) *(v4u*)(Yb + tok * MIXW + GW + col) = w; }
        }
    }
    SEAM(4);
    const bool fuse_final = (FUSE_FINAL != 0) && G == 256 && IN(5) && IN(6);
    if (IN(5)) {
        pg8::Gemm g{Yb, WtOut, MTOK, DM, MIXW};
        if (fuse_final) {
            pg8::PanelOrder S{(int)blockIdx.x};
            pg8::EpiFinal E{args.x, args.out, modacc, args.b_ada, args.g_final, (float*)(ws + WS_CTL + CTL_SS_OFF), (unsigned*)(ws + WS_CTL + CTL_PCNT_OFF), DM};
            pg8::gemm_phase<pg8::EpiFinal, pg8::PanelOrder, true, true>(lds, g, S, E);
        } else {
            pg8::StaticOrder S; S.init(MTOK, DM, G, (int)blockIdx.x);
            pg8::EpiResGate E{args.x, args.out, modacc, args.b_ada, DM};
            pg8::gemm_phase<pg8::EpiResGate, pg8::StaticOrder, true, true>(lds, g, S, E);
            if (REP_MASK & 32) pg8::gemm_phase<pg8::EpiResGate, pg8::StaticOrder, true, true>(lds, g, S, E);
        }
    }
    if (!fuse_final) SEAM(5);
    if (IN(6) && !fuse_final) {
#pragma nounroll
        for (int m = gw; m < MTOK; m += NGW) {
            f32x4* xr = (f32x4*)(args.out + (size_t)m * DM) + lane;
            f32x4 v[16]; float s = 0.f;
#pragma unroll
            for (int j = 0; j < 16; ++j) { v[j] = xr[64 * j]; s += (v[j].x * v[j].x + v[j].y * v[j].y) + (v[j].z * v[j].z + v[j].w * v[j].w); }
            const float rstd = 1.0f / sqrtf(wave_sum(s) * (1.f / DM) + EPS);
#pragma unroll
            for (int j = 0; j < 16; ++j) { const f32x4 gg = *(const f32x4*)(args.g_final + 4 * (64 * j + lane)); xr[64 * j] = v[j] * rstd * gg; }
        }
    }
#undef IN
#undef SEAM
}

extern "C" void kernel_launch(void* const* d_in, const int* in_sizes, int n_in, void* d_out, int out_size, void* d_ws, size_t ws_size, hipStream_t stream) {
    static int grid = 0;
    if (grid == 0) {
        if (n_in != 10 || in_sizes[0] != MTOK * DM || out_size != MTOK * DM || ws_size < WS_END) { fprintf(stderr, "kernel_launch: unexpected shapes / workspace (n_in %d, ws %zu)\n", n_in, ws_size); grid = -1; return; }
        int dev = 0, cus = 0, per_cu = 0;
        if (hipGetDevice(&dev) != hipSuccess || hipDeviceGetAttribute(&cus, hipDeviceAttributeMultiprocessorCount, dev) != hipSuccess) { grid = -1; return; }
        if (hipFuncSetAttribute((const void*)hybrid_fwd, hipFuncAttributeMaxDynamicSharedMemorySize, LDS_BYTES) != hipSuccess) { fprintf(stderr, "kernel_launch: hipFuncSetAttribute failed\n"); grid = -1; return; }
        if (hipOccupancyMaxActiveBlocksPerMultiprocessor(&per_cu, (const void*)hybrid_fwd, NTHREADS, LDS_BYTES) != hipSuccess || per_cu < 1) { fprintf(stderr, "kernel_launch: occupancy query says %d\n", per_cu); per_cu = 1; }
        (void)hipGetLastError();
        grid = cus;
    }
    if (grid < 0) return;
    (void)hipMemsetAsync((char*)d_ws + WS_CTL, 0, CTL_ZERO_BYTES, stream);
    Args a{};
    a.x = (const float*)d_in[0]; a.c = (const float*)d_in[1]; a.w_ada = (const float*)d_in[2]; a.b_ada = (const float*)d_in[3]; a.g_norm = (const float*)d_in[4];
    a.w_in = (const float*)d_in[5]; a.g_sb = (const float*)d_in[6]; a.g_dil = (const float*)d_in[7]; a.w_out = (const float*)d_in[8]; a.g_final = (const float*)d_in[9];
    a.out = (float*)d_out; a.ws = (unsigned char*)d_ws;
#if MK_N_LAUNCHES == 1
    a.ph_lo = 0; a.ph_hi = 7;
    void* kargs[] = {&a};
    hipError_t e = hipLaunchCooperativeKernel((const void*)hybrid_fwd, dim3(grid), dim3(NTHREADS), kargs, LDS_BYTES, stream);
    if (e != hipSuccess) fprintf(stderr, "kernel_launch: cooperative launch failed: %s (grid %d)\n", hipGetErrorString(e), grid);
#else
    for (int ph = 0; ph < 7; ++ph) { a.ph_lo = ph; a.ph_hi = ph + 1; hipLaunchKernelGGL(hybrid_fwd, dim3(grid), dim3(NTHREADS), LDS_BYTES, stream, a); }
#endif
}
```

```cpp
#include <hip/hip_runtime.h>
#include <hip/hip_cooperative_groups.h>
#include <cstdio>
#include <cstdint>
namespace cg = cooperative_groups;

#ifndef MK_N_LAUNCHES
#define MK_N_LAUNCHES 1
#endif
#ifndef REP_MASK
#define REP_MASK 0
#endif
#ifndef SB_EXIT_LOG2
#define SB_EXIT_LOG2 (-70.0f)
#endif
#ifndef ATT_DYNAMIC
#define ATT_DYNAMIC 1
#endif
#ifndef GEMM1_ALIGN_EPI
#define GEMM1_ALIGN_EPI false
#endif
#ifndef FUSE_FINAL
#define FUSE_FINAL 1
#endif
#ifndef USE_CG_SYNC
#define USE_CG_SYNC 0
#endif
#ifndef SB_EARLY_EXIT
#define SB_EARLY_EXIT 1
#endif

namespace pg8 {
#define PG8_LAS __attribute__((address_space(3)))
typedef unsigned short bf16_t;
typedef short bf16x8 __attribute__((ext_vector_type(8)));
typedef float f32x4 __attribute__((ext_vector_type(4)));
typedef unsigned u32x4 __attribute__((ext_vector_type(4)));
constexpr int BM = 256, BK = 64, HALF = 128, HTB = HALF * BK * 2, STAGE_BYTES = 8 * HTB, NXCD = 8, WGM = 8;

__host__ __device__ __forceinline__ int lds_byte(int r, int c) { const int st = (r >> 4) * 2 + (c >> 5), rr = r & 15, cc = c & 31, ob = rr * 64 + cc * 2; return st * 1024 + (ob ^ (((ob >> 9) & 1) << 5)); }
__host__ __device__ __forceinline__ void stage_rc(int b, int& R, int& C) { const int st = b / 1024, sb = b % 1024, swz = sb ^ (((sb >> 9) & 1) << 5); R = (st >> 1) * 16 + swz / 64; C = (st & 1) * 32 + (swz % 64) / 2; }
__host__ __device__ __forceinline__ int perm32(int rho) { const int n = rho >> 4, i = rho & 15; return 8 * (i >> 2) + 4 * n + (i & 3); }

struct Unit { int pm, pn; };
struct Gemm { const bf16_t* A; const bf16_t* Bt; int M, N, K; };

struct StaticOrder {
    int nM, nN, nwg, G, c;
    __host__ __device__ void init(int M, int N, int G_, int c_) { nM = M / BM; nN = N / BM; nwg = nM * nN; G = G_; c = c_; }
    __host__ __device__ bool next(int i, Unit& u) const {
        const long L = (long)i * G + c; if (L >= nwg) return false;
        int wgid = (int)L; { const int q = nwg / NXCD, r = nwg % NXCD, xcd = wgid % NXCD, off = wgid / NXCD; wgid = (xcd < r ? xcd * (q + 1) : r * (q + 1) + (xcd - r) * q) + off; }
        const int nig = WGM * nN, gid = wgid / nig, fm = gid * WGM, gsz = (nM - fm) < WGM ? (nM - fm) : WGM;
        u.pm = fm + ((wgid % nig) % gsz); u.pn = (wgid % nig) / gsz; return true;
    }
    __device__ __forceinline__ void a_ready(const Unit&) const {}
    __device__ __forceinline__ void done(const Unit&) const {}
};

__device__ __forceinline__ unsigned cvt_pk_bf16(float lo, float hi) { unsigned r; asm volatile("v_cvt_pk_bf16_f32 %0, %1, %2" : "=v"(r) : "v"(lo), "v"(hi)); return r; }

struct EpiBf16 {
    static constexpr bool PERM = true, AFTER_DRAIN = false;
    bf16_t* O; size_t slab_stride;
    __device__ __forceinline__ void operator()(const f32x4 (&acc)[2][2][4][2], const Unit& u, int wr, int wc, int fr, int fq) const {
        const int colt = u.pn * BM, t = colt >> 11, h0 = (colt & 2047) >> 7, d = wc * 32 + 8 * fq;
        const int b = u.pm >> 3, s0 = (u.pm & 7) * BM + wr * 64 + fr;
        bf16_t* base = O + (size_t)t * slab_stride + ((size_t)(b * 16 + h0) * 2048 + s0) * 128 + d;
#pragma unroll
        for (int ai = 0; ai < 2; ++ai)
#pragma unroll
            for (int m = 0; m < 4; ++m) { bf16_t* rowp = base + (size_t)(ai * HALF + m * 16) * 128;
#pragma unroll
                for (int bj = 0; bj < 2; ++bj) { const f32x4 v0 = acc[ai][bj][m][0], v1 = acc[ai][bj][m][1];
                    u32x4 w; w.x = cvt_pk_bf16(v0[0], v0[1]); w.y = cvt_pk_bf16(v0[2], v0[3]); w.z = cvt_pk_bf16(v1[0], v1[1]); w.w = cvt_pk_bf16(v1[2], v1[3]);
                    *(u32x4*)(rowp + (size_t)bj * 2048 * 128) = w; } }
    }
};
struct EpiResGate {
    static constexpr bool PERM = true, AFTER_DRAIN = false;
    const float* x; float* out; const float* modacc; const float* b_ada; int ldc;
    __device__ __forceinline__ void operator()(const f32x4 (&acc)[2][2][4][2], const Unit& u, int wr, int wc, int fr, int fq) const {
        const int row0 = u.pm * BM + wr * 64 + fr, col0 = u.pn * BM + wc * 32 + 8 * fq, b = u.pm >> 3;
        f32x4 gv[2][2];
#pragma unroll
        for (int bj = 0; bj < 2; ++bj)
#pragma unroll
            for (int n = 0; n < 2; ++n) gv[bj][n] = *(const f32x4*)(modacc + (size_t)b * 12288 + 8192 + col0 + bj * HALF + 4 * n) + *(const f32x4*)(b_ada + 8192 + col0 + bj * HALF + 4 * n);
#pragma unroll
        for (int ai = 0; ai < 2; ++ai)
#pragma unroll
            for (int m = 0; m < 4; ++m) { const size_t off = (size_t)(row0 + ai * HALF + m * 16) * ldc + col0;
#pragma unroll
                for (int bj = 0; bj < 2; ++bj)
#pragma unroll
                    for (int n = 0; n < 2; ++n) { const f32x4 xv = *(const f32x4*)(x + off + bj * HALF + 4 * n);
                        *(f32x4*)(out + off + bj * HALF + 4 * n) = xv + gv[bj][n] * acc[ai][bj][m][n]; } }
    }
};

struct EpiFinal {
    static constexpr bool PERM = true, AFTER_DRAIN = false;
    const float* x; float* out; const float* modacc; const float* b_ada; const float* g_final; float* ss; unsigned* cnt; int ldc;
    __device__ __forceinline__ void operator()(f32x4 (&acc)[2][2][4][2], const Unit& u, int wr, int wc, int fr, int fq) const {
        const int row0 = u.pm * BM + wr * 64 + fr, col0 = u.pn * BM + wc * 32 + 8 * fq, b = u.pm >> 3;
        {
        f32x4 gv[2][2];
#pragma unroll
        for (int bj = 0; bj < 2; ++bj)
#pragma unroll
            for (int n = 0; n < 2; ++n) gv[bj][n] = *(const f32x4*)(modacc + (size_t)b * 12288 + 8192 + col0 + bj * HALF + 4 * n) + *(const f32x4*)(b_ada + 8192 + col0 + bj * HALF + 4 * n);
#pragma unroll
        for (int ai = 0; ai < 2; ++ai)
#pragma unroll
            for (int m = 0; m < 4; ++m) { const int row = row0 + ai * HALF + m * 16; const size_t off = (size_t)row * ldc + col0; float rs = 0.f;
#pragma unroll
                for (int bj = 0; bj < 2; ++bj)
#pragma unroll
                    for (int n = 0; n < 2; ++n) { const f32x4 xv = *(const f32x4*)(x + off + bj * HALF + 4 * n); const f32x4 v = xv + gv[bj][n] * acc[ai][bj][m][n];
                        acc[ai][bj][m][n] = v; rs += (v[0] * v[0] + v[1] * v[1]) + (v[2] * v[2] + v[3] * v[3]); }
                rs += __shfl_xor(rs, 16); rs += __shfl_xor(rs, 32);
                if (fq == 0) __hip_atomic_fetch_add(ss + row, rs, __ATOMIC_RELAXED, __HIP_MEMORY_SCOPE_AGENT); }
        }
        asm volatile("s_waitcnt vmcnt(0)" ::: "memory");
        unsigned* c = cnt + 64 * u.pm;
        if ((threadIdx.x & 63) == 0) __hip_atomic_fetch_add(c, 1u, __ATOMIC_RELAXED, __HIP_MEMORY_SCOPE_AGENT);
        { unsigned sp = 0; while (__hip_atomic_load(c, __ATOMIC_RELAXED, __HIP_MEMORY_SCOPE_AGENT) < 128u) { __builtin_amdgcn_s_sleep(2); if (++sp > (1u << 22)) break; } }
        __builtin_amdgcn_fence(__ATOMIC_ACQUIRE, "agent");
        f32x4 gf[2][2];
#pragma unroll
        for (int bj = 0; bj < 2; ++bj)
#pragma unroll
            for (int n = 0; n < 2; ++n) gf[bj][n] = *(const f32x4*)(g_final + col0 + bj * HALF + 4 * n);
#pragma unroll
        for (int ai = 0; ai < 2; ++ai)
#pragma unroll
            for (int m = 0; m < 4; ++m) { const int row = row0 + ai * HALF + m * 16; const size_t off = (size_t)row * ldc + col0;
                const float rstd = 1.0f / sqrtf(__hip_atomic_load(ss + row, __ATOMIC_RELAXED, __HIP_MEMORY_SCOPE_AGENT) * (1.0f / 4096.0f) + 1e-6f);
#pragma unroll
                for (int bj = 0; bj < 2; ++bj)
#pragma unroll
                    for (int n = 0; n < 2; ++n) *(f32x4*)(out + off + bj * HALF + 4 * n) = acc[ai][bj][m][n] * rstd * gf[bj][n]; }
    }
};
struct PanelOrder {
    int c;
    __device__ bool next(int i, Unit& u) const { if (i >= 2) return false; const int xcd = c & 7, off = c >> 3; u.pm = 4 * (xcd >> 1) + (off & 3) + 16 * i; u.pn = 8 * (xcd & 1) + (off >> 2); return true; }
    __device__ __forceinline__ void a_ready(const Unit&) const {}
    __device__ __forceinline__ void done(const Unit&) const {}
};

template <class Epi, class Sched, bool ALIGN_EPI = false, bool SP2 = false>
__device__ __forceinline__ void gemm_phase(PG8_LAS unsigned char* lds, const Gemm g, const Sched& S, const Epi& E) {
    const int tid = threadIdx.x, wid = __builtin_amdgcn_readfirstlane(tid >> 6), lane = tid & 63, wr = wid >> 2, wc = wid & 3, fr = lane & 15, fq = lane >> 4;
    const int K = g.K, nt = K / BK;
    unsigned voffA[2], voffB[2];
#pragma unroll
    for (int i = 0; i < 2; ++i) { int R, C; stage_rc(tid * 16 + i * 8192, R, C); const int Rb = Epi::PERM ? ((R & ~31) + perm32(R & 31)) : R;
        voffA[i] = (unsigned)(R * K + C) * 2u; voffB[i] = (unsigned)(Rb * K + C) * 2u; }
    const size_t kstep = (size_t)(BK * 2);
    const size_t hstep = (size_t)HALF * K * 2;
    const size_t tstep = 2 * hstep;
    const unsigned ldsw = (unsigned)wid * 1024u;
    const int aoff = lds_byte(wr * 64 + fr, fq * 8), boff = lds_byte(wc * 32 + fr, fq * 8);
#define PG8_SA(b, h) (((b) * 2 + (h)) * HTB)
#define PG8_SB(b, h) ((4 + (b) * 2 + (h)) * HTB)
#define PG8_STAGE(bufoff, gbase, voff) do { _Pragma("unroll") for (int _i = 0; _i < 2; ++_i) \
        __builtin_amdgcn_global_load_lds((const unsigned*)((const char*)(gbase) + (voff)[_i]), (PG8_LAS unsigned*)(lds + (bufoff) + ldsw + _i * 8192), 16, 0, 0); } while (0)
#define PG8_LDA(dst, b, h) do { _Pragma("unroll") for (int m = 0; m < 4; ++m) _Pragma("unroll") for (int k = 0; k < 2; ++k) dst[m][k] = *(const PG8_LAS bf16x8*)(lds + PG8_SA(b, h) + aoff + m * 2048 + k * 1024); } while (0)
#define PG8_LDB(dst, b, h) do { _Pragma("unroll") for (int n = 0; n < 2; ++n) _Pragma("unroll") for (int k = 0; k < 2; ++k) dst[n][k] = *(const PG8_LAS bf16x8*)(lds + PG8_SB(b, h) + boff + n * 2048 + k * 1024); } while (0)
#define PG8_MMA(ai, bj, At, Bt) do { __builtin_amdgcn_s_setprio(1); _Pragma("unroll") for (int m = 0; m < 4; ++m) _Pragma("unroll") for (int n = 0; n < 2; ++n) _Pragma("unroll") for (int k = 0; k < 2; ++k) \
        acc[ai][bj][m][n] = __builtin_amdgcn_mfma_f32_16x16x32_bf16(Bt[n][k], At[m][k], acc[ai][bj][m][n], 0, 0, 0); __builtin_amdgcn_s_setprio(0); } while (0)
#define PG8_WAIT_V(n) asm volatile("s_waitcnt vmcnt(" #n ")" ::: "memory")
#define PG8_WAIT_L(n) asm volatile("s_waitcnt lgkmcnt(" #n ")" ::: "memory")
#define PG8_BAR __builtin_amdgcn_s_barrier()
#define PG8_SCHED __builtin_amdgcn_sched_barrier(0)
    Unit cur, nxt; int ui = 0;
    if (!S.next(0, cur)) return;
    f32x4 acc[2][2][4][2];
#pragma unroll
    for (int a = 0; a < 2; ++a)
#pragma unroll
        for (int b = 0; b < 2; ++b)
#pragma unroll
            for (int m = 0; m < 4; ++m)
#pragma unroll
                for (int n = 0; n < 2; ++n) acc[a][b][m][n] = (f32x4){0.f, 0.f, 0.f, 0.f};
    bf16x8 At[4][2], B0[2][2], B1[2][2];
    const char* cA = (const char*)g.A + (size_t)cur.pm * tstep; const char* cB = (const char*)g.Bt + (size_t)cur.pn * tstep;
    S.a_ready(cur);
    if constexpr (SP2) {
        PG8_STAGE(PG8_SB(0, 0), cB, voffB); PG8_STAGE(PG8_SB(0, 1), cB + hstep, voffB); PG8_STAGE(PG8_SA(0, 0), cA, voffA); PG8_STAGE(PG8_SA(0, 1), cA + hstep, voffA);
        if (wr == 1) PG8_BAR;
        PG8_WAIT_V(2); PG8_BAR;
        PG8_STAGE(PG8_SB(1, 0), cB + kstep, voffB); PG8_STAGE(PG8_SA(1, 0), cA + kstep, voffA); PG8_STAGE(PG8_SB(1, 1), cB + hstep + kstep, voffB);
        PG8_WAIT_V(6); PG8_BAR;
    } else {
        PG8_STAGE(PG8_SB(0, 0), cB, voffB); PG8_STAGE(PG8_SA(0, 0), cA, voffA); PG8_STAGE(PG8_SB(0, 1), cB + hstep, voffB); PG8_STAGE(PG8_SA(0, 1), cA + hstep, voffA);
        if (wr == 1) PG8_BAR;
        PG8_WAIT_V(4); PG8_BAR;
        PG8_STAGE(PG8_SB(1, 0), cB + kstep, voffB); PG8_STAGE(PG8_SA(1, 0), cA + kstep, voffA); PG8_STAGE(PG8_SB(1, 1), cB + hstep + kstep, voffB);
        PG8_WAIT_V(6); PG8_BAR;
    }
    for (;;) {
        const bool has_next = S.next(ui + 1, nxt);
        const char* nA = has_next ? (const char*)g.A + (size_t)nxt.pm * tstep : cA; const char* nB = has_next ? (const char*)g.Bt + (size_t)nxt.pn * tstep : cB;
        for (int t = 0; t < nt; t += 2) {
            const bool last = (t == nt - 2);
            const char* a1 = cA + (size_t)(t + 1) * kstep;
            const char* a2 = last ? nA : cA + (size_t)(t + 2) * kstep; const char* b2 = last ? nB : cB + (size_t)(t + 2) * kstep;
            const char* a3 = a2 + kstep; const char* b3 = b2 + kstep;
            if (last && has_next) S.a_ready(nxt);
            if constexpr (SP2) {
            PG8_LDB(B0, 0, 0); PG8_LDB(B1, 0, 1); PG8_SCHED; PG8_LDA(At, 0, 0); PG8_STAGE(PG8_SA(1, 1), a1 + hstep, voffA);
            PG8_WAIT_V(8); PG8_WAIT_L(0); PG8_BAR; PG8_MMA(0, 0, At, B0); PG8_MMA(0, 1, At, B1); PG8_BAR; PG8_SCHED;
            PG8_LDA(At, 0, 1); PG8_STAGE(PG8_SB(0, 0), b2, voffB); PG8_STAGE(PG8_SB(0, 1), b2 + hstep, voffB); PG8_STAGE(PG8_SA(0, 0), a2, voffA);
            PG8_WAIT_V(8); PG8_WAIT_L(0); PG8_BAR; PG8_MMA(1, 0, At, B0); PG8_MMA(1, 1, At, B1); PG8_BAR; PG8_SCHED;
            PG8_LDB(B0, 1, 0); PG8_LDB(B1, 1, 1); PG8_SCHED; PG8_LDA(At, 1, 0); PG8_STAGE(PG8_SA(0, 1), a2 + hstep, voffA);
            PG8_WAIT_V(8); PG8_WAIT_L(0); PG8_BAR; PG8_MMA(0, 0, At, B0); PG8_MMA(0, 1, At, B1); PG8_BAR; PG8_SCHED;
            PG8_LDA(At, 1, 1); PG8_STAGE(PG8_SB(1, 0), b3, voffB); PG8_STAGE(PG8_SB(1, 1), b3 + hstep, voffB); PG8_STAGE(PG8_SA(1, 0), a3, voffA);
            PG8_WAIT_V(8); PG8_WAIT_L(0); PG8_BAR; PG8_MMA(1, 0, At, B0); PG8_MMA(1, 1, At, B1); PG8_BAR; PG8_SCHED;
            } else {
            PG8_LDB(B0, 0, 0); PG8_SCHED; PG8_LDA(At, 0, 0); PG8_STAGE(PG8_SA(1, 1), a1 + hstep, voffA);
            PG8_WAIT_L(8); PG8_BAR; PG8_WAIT_L(0); PG8_MMA(0, 0, At, B0); PG8_BAR; PG8_SCHED;
            PG8_LDB(B1, 0, 1); PG8_STAGE(PG8_SB(0, 0), b2, voffB);
            PG8_BAR; PG8_WAIT_L(0); PG8_MMA(0, 1, At, B1); PG8_BAR;
            PG8_LDA(At, 0, 1); PG8_STAGE(PG8_SA(0, 0), a2, voffA);
            PG8_BAR; PG8_WAIT_L(0); PG8_MMA(1, 0, At, B0); PG8_BAR; PG8_SCHED;
            PG8_STAGE(PG8_SB(0, 1), b2 + hstep, voffB);
            PG8_WAIT_V(6); PG8_BAR; PG8_MMA(1, 1, At, B1); PG8_BAR;
            PG8_LDB(B0, 1, 0); PG8_SCHED; PG8_LDA(At, 1, 0); PG8_STAGE(PG8_SA(0, 1), a2 + hstep, voffA);
            PG8_WAIT_L(8); PG8_BAR; PG8_WAIT_L(0); PG8_MMA(0, 0, At, B0); PG8_BAR; PG8_SCHED;
            PG8_LDB(B1, 1, 1); PG8_STAGE(PG8_SB(1, 0), b3, voffB);
            PG8_BAR; PG8_WAIT_L(0); PG8_MMA(0, 1, At, B1); PG8_BAR;
            PG8_LDA(At, 1, 1); PG8_STAGE(PG8_SA(1, 0), a3, voffA);
            PG8_BAR; PG8_WAIT_L(0); PG8_MMA(1, 0, At, B0); PG8_BAR; PG8_SCHED;
            PG8_STAGE(PG8_SB(1, 1), b3 + hstep, voffB);
            PG8_WAIT_V(6); PG8_BAR; PG8_MMA(1, 1, At, B1); PG8_BAR;
            }
        }
        if constexpr (ALIGN_EPI) { if (wr == 0) PG8_BAR; }
        if constexpr (!Epi::AFTER_DRAIN) { E(acc, cur, wr, wc, fr, fq); S.done(cur); }
        if (!has_next) break;
#pragma unroll
        for (int a = 0; a < 2; ++a)
#pragma unroll
            for (int b = 0; b < 2; ++b)
#pragma unroll
                for (int m = 0; m < 4; ++m)
#pragma unroll
                    for (int n = 0; n < 2; ++n) acc[a][b][m][n] = (f32x4){0.f, 0.f, 0.f, 0.f};
        cur = nxt; cA = nA; cB = nB; ++ui;
        if constexpr (ALIGN_EPI) { if (wr == 1) PG8_BAR; }
    }
    PG8_WAIT_V(0);
    if constexpr (!ALIGN_EPI) { if (wr == 0) PG8_BAR; }
    PG8_BAR;
#undef PG8_SA
#undef PG8_SB
#undef PG8_STAGE
#undef PG8_LDA
#undef PG8_LDB
#undef PG8_MMA
#undef PG8_WAIT_V
#undef PG8_WAIT_L
#undef PG8_BAR
#undef PG8_SCHED
}
}

#define LAS __attribute__((address_space(3)))
typedef unsigned short bf16;
typedef unsigned v4u __attribute__((ext_vector_type(4)));
typedef unsigned v2u __attribute__((ext_vector_type(2)));
typedef float f32x4 __attribute__((ext_vector_type(4)));
typedef float f32x16 __attribute__((ext_vector_type(16)));
typedef short bf16x8 __attribute__((ext_vector_type(8)));
typedef short s16x4 __attribute__((ext_vector_type(4)));

constexpr int NWAVES = 8, NTHREADS = NWAVES * 64;
constexpr int DM = 4096, BATCH = 4, SEQ = 2048, MTOK = BATCH * SEQ, HD = 128, NH = 16, GW = NH * HD  , INC = 8 * GW  , MIXW = 2 * GW;
constexpr float EPS = 1e-6f;
constexpr size_t MiB = 1u << 20;
constexpr size_t WS_CTL = 0, CTL_ZERO_BYTES = 1 * MiB;
constexpr size_t CTL_BAR_OFF = 16384;
constexpr size_t CTL_MOD_OFF = 65536;
constexpr size_t CTL_SS_OFF = 524288, CTL_PCNT_OFF = 589824;
constexpr size_t WS_WTIN = 2 * MiB, WS_WTOUT = 130 * MiB, WS_H = 162 * MiB, WS_PROJ = 226 * MiB, WS_Y = 482 * MiB, WS_OPART = 546 * MiB, WS_LPART = 642 * MiB, WS_END = 644 * MiB;
constexpr size_t PROJ_STRIDE = (size_t)MTOK * GW;
enum { T_SBQ = 0, T_SBK, T_SBV, T_SBZ, T_DLQ, T_DLK, T_DLV, T_DLZ };
constexpr int LDS_MISC_OFF = 131072;
constexpr int LDS_BYTES = 147456;

__device__ __forceinline__ unsigned f2bf(float f) { unsigned u = __builtin_bit_cast(unsigned, f); return (u + 0x7fffu + ((u >> 16) & 1u)) >> 16; }
__device__ __forceinline__ unsigned pk2(float lo, float hi) { return f2bf(lo) | (f2bf(hi) << 16); }
__device__ __forceinline__ float bf2f(unsigned short h) { return __builtin_bit_cast(float, (unsigned)h << 16); }
__device__ __forceinline__ float bflo(unsigned w) { return __builtin_bit_cast(float, w << 16); }
__device__ __forceinline__ float bfhi(unsigned w) { return __builtin_bit_cast(float, w & 0xffff0000u); }
__device__ __forceinline__ float wave_sum(float v) {
#pragma unroll
    for (int o = 1; o < 64; o <<= 1) v += __shfl_xor(v, o);
    return v;
}
__device__ __forceinline__ float silu_f(float z) { return z * __builtin_amdgcn_rcpf(1.0f + __builtin_amdgcn_exp2f(-1.4426950408889634f * z)); }
#define LDS_WAIT() asm volatile("s_waitcnt lgkmcnt(0)" ::: "memory")

__device__ __forceinline__ void p0_transpose_item(const float* W, int K, int N, bf16* WT, LAS float* scr, int item, int lane) {
    const int nblk = N / 32, kb = item / nblk, nb = item % nblk, k0 = 64 * kb, n0 = 32 * nb;
#pragma unroll 8
    for (int i = 0; i < 32; ++i) { const int kk = 2 * i + (lane >> 5); scr[kk * 33 + (lane & 31)] = __builtin_nontemporal_load(&W[(size_t)(k0 + kk) * N + n0 + (lane & 31)]); }
    LDS_WAIT(); asm volatile("" ::: "memory");
    const int c = lane & 7;
#pragma unroll
    for (int j = 0; j < 4; ++j) { const int n = (lane >> 3) + 8 * j; const LAS float* s = scr + (8 * c) * 33 + n;
        v4u o; o.x = pk2(s[0 * 33], s[1 * 33]); o.y = pk2(s[2 * 33], s[3 * 33]); o.z = pk2(s[4 * 33], s[5 * 33]); o.w = pk2(s[6 * 33], s[7 * 33]);
        *(v4u*)(WT + (size_t)(n0 + n) * K + k0 + 8 * c) = o; }
    LDS_WAIT(); asm volatile("" ::: "memory");
}
__device__ __forceinline__ void p0_mod_item(const float* c, const float* w_ada, float* modacc, LAS float* scr, int item, int lane) {
    const int nc = item % 48, kc = item / 48, n0 = nc * 256 + lane * 4, k0 = kc * 128;
#pragma unroll
    for (int i = 0; i < 8; ++i) { const int idx = i * 64 + lane, b = idx >> 7, k = idx & 127; scr[idx] = silu_f(c[b * DM + k0 + k]); }
    LDS_WAIT(); asm volatile("" ::: "memory");
    f32x4 a0 = {0.f, 0.f, 0.f, 0.f}, a1 = a0, a2 = a0, a3 = a0;
    const float* wp = w_ada + (size_t)k0 * 12288 + n0;
#pragma unroll 8
    for (int k = 0; k < 128; ++k) { const f32x4 w = __builtin_nontemporal_load((const f32x4*)(wp + (size_t)k * 12288));
        a0 += w * scr[k]; a1 += w * scr[128 + k]; a2 += w * scr[256 + k]; a3 += w * scr[384 + k]; }
#pragma unroll
    for (int j = 0; j < 4; ++j) {
        __hip_atomic_fetch_add(modacc + 0 * 12288 + n0 + j, a0[j], __ATOMIC_RELAXED, __HIP_MEMORY_SCOPE_AGENT);
        __hip_atomic_fetch_add(modacc + 1 * 12288 + n0 + j, a1[j], __ATOMIC_RELAXED, __HIP_MEMORY_SCOPE_AGENT);
        __hip_atomic_fetch_add(modacc + 2 * 12288 + n0 + j, a2[j], __ATOMIC_RELAXED, __HIP_MEMORY_SCOPE_AGENT);
        __hip_atomic_fetch_add(modacc + 3 * 12288 + n0 + j, a3[j], __ATOMIC_RELAXED, __HIP_MEMORY_SCOPE_AGENT); }
    LDS_WAIT(); asm volatile("" ::: "memory");
}
__device__ __forceinline__ void p1_row(const float* xrow, const float* g, const float* modb, const float* b_ada, bf16* orow, int lane) {
    const f32x4* xr = (const f32x4*)xrow + lane;
    float s = 0.f;
#pragma unroll 8
    for (int j = 0; j < 16; ++j) { const f32x4 v = xr[64 * j]; s += (v.x * v.x + v.y * v.y) + (v.z * v.z + v.w * v.w); }
    const float rstd = 1.0f / sqrtf(wave_sum(s) * (1.f / DM) + EPS);
    unsigned long long* o8 = (unsigned long long*)orow + lane;
    const float* gp = g + 4 * lane; const float* mp = modb + 4 * lane; const float* bp = b_ada + 4 * lane;
#pragma nounroll
    for (int jo = 0; jo < 16; jo += 4) {
        f32x4 v[4], gg[4], sh[4], sc[4];
#pragma unroll
        for (int ji = 0; ji < 4; ++ji) { const int j = jo + ji;
            v[ji] = xr[64 * j]; gg[ji] = *(const f32x4*)(gp + 256 * j);
            sh[ji] = *(const f32x4*)(mp + 256 * j) + *(const f32x4*)(bp + 256 * j); sc[ji] = *(const f32x4*)(mp + DM + 256 * j) + *(const f32x4*)(bp + DM + 256 * j) + 1.0f; }
#pragma unroll
        for (int ji = 0; ji < 4; ++ji) { const f32x4 h = v[ji] * rstd * gg[ji] * sc[ji] + sh[ji];
            o8[64 * (jo + ji)] = (unsigned long long)pk2(h.x, h.y) | ((unsigned long long)pk2(h.z, h.w) << 32); }
    }
}

constexpr float C2Q = 1.4426950408889634f * 0.08838834764831845f;
typedef __bf16 bf16x2_t __attribute__((ext_vector_type(2))); typedef float f32x2_t __attribute__((ext_vector_type(2)));
__device__ __forceinline__ unsigned cvtpk_s(float lo, float hi) { f32x2_t v = {lo, hi}; bf16x2_t b = __builtin_convertvector(v, bf16x2_t); return __builtin_bit_cast(unsigned, b); }
__device__ __forceinline__ int crow(int r, int hi) { return (r & 3) + 8 * (r >> 2) + 4 * hi; }
__device__ __forceinline__ void swap32(float x, float& lo, float& hi_) { auto rr = __builtin_amdgcn_permlane32_swap(__float_as_uint(x), __float_as_uint(x), false, false); lo = __uint_as_float(rr[0]); hi_ = __uint_as_float(rr[1]); }
typedef short v4i16_t __attribute__((ext_vector_type(4)));
__device__ __forceinline__ s16x4 vtr(LAS const unsigned char* p) { return __builtin_bit_cast(s16x4, __builtin_amdgcn_ds_read_tr16_b64_v4i16((LAS v4i16_t*)p)); }

__device__ __forceinline__ f32x16 qk_tile(const bf16x8 (&kf)[8], const bf16x8 (&qf)[8]) {
    f32x16 s0 = {}, s1 = {};
#pragma unroll
    for (int kk = 0; kk < 8; kk += 2) { s0 = __builtin_amdgcn_mfma_f32_32x32x16_bf16(kf[kk], qf[kk], s0, 0, 0, 0); s1 = __builtin_amdgcn_mfma_f32_32x32x16_bf16(kf[kk + 1], qf[kk + 1], s1, 0, 0, 0); }
    return s0 + s1;
}
__device__ __forceinline__ void pv_lane_offsets(unsigned (&tro)[4][2], int lane) {
    const int h = lane >> 5, blk = (lane >> 4) & 1, q4 = (lane & 15) >> 2, pp = lane & 3;
#pragma unroll
    for (int c = 0; c < 4; ++c)
#pragma unroll
        for (int t = 0; t < 2; ++t) { tro[c][t] = 256u * (unsigned)(8 * h + 4 * t + q4) + 16u * (unsigned)((4 * c + 2 * blk + (pp >> 1)) ^ ((q4 << 2) | (2 * h + t))) + 8u * (unsigned)(pp & 1);
            asm volatile("" : "+v"(tro[c][t])); }
}
__device__ __forceinline__ void pv_tile(f32x16 (&o)[4], const f32x16& p, LAS const unsigned char* vl, const unsigned (&tro)[4][2]) {
    const unsigned base = (unsigned)(uintptr_t)vl;
    unsigned pw[8];
#pragma unroll
    for (int i = 0; i < 8; ++i) pw[i] = cvtpk_s(p[2 * i], p[2 * i + 1]);
    unsigned ad[4][2];
#pragma unroll
    for (int c = 0; c < 4; ++c)
#pragma unroll
        for (int t = 0; t < 2; ++t) ad[c][t] = base + tro[c][t];
    s16x4 tr[2][4][2];
#pragma unroll
    for (int ks = 0; ks < 2; ++ks)
#pragma unroll
        for (int c = 0; c < 4; ++c)
#pragma unroll
            for (int t = 0; t < 2; ++t) asm volatile("ds_read_b64_tr_b16 %0, %1 offset:%2" : "=&v"(tr[ks][c][t]) : "v"(ad[c][t]), "i"(ks * 4096) : "memory");
    asm volatile("s_waitcnt lgkmcnt(0)" ::: "memory"); __builtin_amdgcn_sched_barrier(0);
#pragma unroll
    for (int ks = 0; ks < 2; ++ks) {
        const v4u pb = {pw[4 * ks], pw[4 * ks + 1], pw[4 * ks + 2], pw[4 * ks + 3]};
        const bf16x8 pf = __builtin_bit_cast(bf16x8, pb);
#pragma unroll
        for (int c = 0; c < 4; ++c) {
            const bf16x8 vf = {tr[ks][c][0][0], tr[ks][c][0][1], tr[ks][c][0][2], tr[ks][c][0][3], tr[ks][c][1][0], tr[ks][c][1][1], tr[ks][c][1][2], tr[ks][c][1][3]};
            o[c] = __builtin_amdgcn_mfma_f32_32x32x16_bf16(vf, pf, o[c], 0, 0, 0);
        }
    }
}

struct AttnP { const bf16* proj; bf16* Y; bf16* opart; float* lpart; const float* g_sb; };

constexpr int RING_D = 3, STAGE_B = 16384, RING_FLAGS_OFF = 2 * RING_D * STAGE_B;
#define ATT_BAR() asm volatile("s_waitcnt lgkmcnt(0)\n\ts_barrier" ::: "memory")
template <bool SB>
__device__ __forceinline__ void attn_unit(const AttnP& P, int p, int uid, LAS unsigned char* ring, int wave, int lane) {
    const int r32 = lane & 31, hi = lane >> 5, team = wave >> 2, qi = team ? 3 - (wave & 3) : (wave & 3);
    int r, q0, n, bh0, bh1, rho0, rho1;
    if (SB || p == 0) { const int bp = uid >> 4, k = uid & 15; r = 1; bh0 = 2 * bp; bh1 = bh0 + 1; rho0 = 0; rho1 = 0; q0 = 4 * k; n = SB ? 4 * k + 4 : (4 * k + 4 < 8 ? 4 * k + 4 : 8); }
    else if (p == 1) { const int bhh = uid >> 3, rp = (uid >> 2) & 1, k = uid & 3; r = 4; bh0 = bhh; bh1 = bhh; rho0 = 2 * rp; rho1 = rho0 + 1; q0 = 4 * k; n = 4 * k + 4 < 8 ? 4 * k + 4 : 8; }
    else { const int bhh = uid >> 3, pr = uid & 7; r = 16; bh0 = bhh; bh1 = bhh; rho0 = 2 * pr; rho1 = rho0 + 1; q0 = 0; n = 4; }
    const int bh = team ? bh1 : bh0, rho_w = team ? rho1 : rho0, b = bh >> 4, h = bh & 15, qblk_w = q0 + qi, top = q0 + 3;
    const size_t rs = (size_t)r * HD, hb = (size_t)bh * SEQ * HD;
    const size_t sb0 = (size_t)bh0 * SEQ * HD + (size_t)rho0 * HD, sb1 = (size_t)bh1 * SEQ * HD + (size_t)rho1 * HD;
    const bf16* Qs = P.proj + (SB ? T_SBQ : T_DLQ) * PROJ_STRIDE; const bf16* Ks = P.proj + (SB ? T_SBK : T_DLK) * PROJ_STRIDE; const bf16* Vs = P.proj + (SB ? T_SBV : T_DLV) * PROJ_STRIDE;
    bf16x8 qf[8];
    { const bf16* qp = Qs + hb + (size_t)rho_w * HD + (size_t)(32 * qblk_w + r32) * rs + 8 * hi;
#pragma unroll
      for (int kk = 0; kk < 8; ++kk) qf[kk] = *(const bf16x8*)(qp + 16 * kk); }
    const int q4 = lane >> 4, pc = lane & 15, krow = 4 * wave + q4, wp = (wave & 4) | ((wave & 1) << 1) | ((wave >> 1) & 1), vkey = 4 * wp + q4;
    const size_t koff = (size_t)krow * rs + (size_t)((pc ^ (krow & 15)) * 8), voff = (size_t)vkey * rs + (size_t)((pc ^ ((q4 << 2) | (wave & 3))) * 8);
#define ISSUE(j) do { const size_t tt_ = (size_t)(32 * (top - (j))) * rs; LAS unsigned char* st_ = ring + (((j) % RING_D) * 2) * STAGE_B + wave * 1024; \
        __builtin_amdgcn_global_load_lds((const unsigned*)(Ks + sb0 + tt_ + koff), (LAS unsigned*)st_, 16, 0, 0); \
        __builtin_amdgcn_global_load_lds((const unsigned*)(Vs + sb0 + tt_ + voff), (LAS unsigned*)(st_ + 8192), 16, 0, 0); \
        __builtin_amdgcn_global_load_lds((const unsigned*)(Ks + sb1 + tt_ + koff), (LAS unsigned*)(st_ + STAGE_B), 16, 0, 0); \
        __builtin_amdgcn_global_load_lds((const unsigned*)(Vs + sb1 + tt_ + voff), (LAS unsigned*)(st_ + STAGE_B + 8192), 16, 0, 0); } while (0)
    ISSUE(0); if (1 < n) ISSUE(1);
    f32x16 o[4]; o[0] = f32x16{}; o[1] = f32x16{}; o[2] = f32x16{}; o[3] = f32x16{};
    float carry = 0.f, m = -INFINITY, lsum = 0.f; bool done = false;
    const float slope2 = __builtin_amdgcn_exp2f(-0.5f * (float)(h + 1)) * 1.4426950408889634f * (float)r;
    float nb[16];
#pragma unroll
    for (int q = 0; q < 16; ++q) nb[q] = SB ? 0.f : -slope2 * (float)(r32 - crow(q, hi));
    LAS unsigned* flags = (LAS unsigned*)(ring + RING_FLAGS_OFF);
    unsigned tro[4][2]; pv_lane_offsets(tro, lane);
    unsigned kro[8];
#pragma unroll
    for (int kk = 0; kk < 8; ++kk) { kro[kk] = 256u * (unsigned)r32 + 16u * (unsigned)((2 * kk + hi) ^ (r32 & 15)); asm volatile("" : "+v"(kro[kk])); }
#pragma nounroll
    for (int j = 0; j < n; ++j) {
        if (j > 0 && j + 1 < n) asm volatile("s_waitcnt vmcnt(4)" ::: "memory"); else asm volatile("s_waitcnt vmcnt(0)" ::: "memory");
        ATT_BAR();
        if (SB && j > 0) { const v4u f0 = *(LAS v4u*)(flags + 8 * ((j - 1) & 1)), f1 = *(LAS v4u*)(flags + 8 * ((j - 1) & 1) + 4);
            if ((f0.x & f0.y & f0.z & f0.w & f1.x & f1.y & f1.z & f1.w) != 0u) break; }
        if (j + 2 < n) ISSUE(j + 2);
        const int tau = top - j, del = qblk_w - tau;
        if (del >= 0 && (SB ? !done : del <= 4)) {
            LAS const unsigned char* st = ring + ((j % RING_D) * 2 + team) * STAGE_B;
            bf16x8 kf[8];
#pragma unroll
            for (int kk = 0; kk < 8; ++kk) kf[kk] = *(LAS const bf16x8*)(st + kro[kk]);
            f32x16 s = qk_tile(kf, qf);
            if (SB) {
                float l[16];
#pragma unroll
                for (int q = 0; q < 16; ++q) { const float z2 = s[q] * C2Q, u = __builtin_amdgcn_logf(1.0f + __builtin_amdgcn_exp2f(-__builtin_fabsf(z2)));
                    l[q] = -(__builtin_fmaxf(z2, 0.f) + u); s[q] = z2 + l[q]; }
                if (del == 0) {
#pragma unroll
                    for (int q = 0; q < 16; ++q) if (!(crow(q, hi) < r32)) { l[q] = 0.f; s[q] = -INFINITY; }
                }
                float a[4], bb[4];
#pragma unroll
                for (int i = 0; i < 4; ++i) swap32((l[4 * i] + l[4 * i + 1]) + (l[4 * i + 2] + l[4 * i + 3]), a[i], bb[i]);
                float E[4]; E[3] = 0.f; E[2] = a[3] + bb[3]; E[1] = E[2] + (a[2] + bb[2]); E[0] = E[1] + (a[1] + bb[1]);
                const float tot = E[0] + (a[0] + bb[0]);
#pragma unroll
                for (int i = 0; i < 4; ++i) { const float T = carry + E[i] + (hi == 0 ? bb[i] : 0.f);
                    const float s3 = T, s2 = s3 + l[4 * i + 3], s1 = s2 + l[4 * i + 2], s0 = s1 + l[4 * i + 1];
                    s[4 * i + 3] = __builtin_amdgcn_exp2f(s[4 * i + 3] + s3); s[4 * i + 2] = __builtin_amdgcn_exp2f(s[4 * i + 2] + s2);
                    s[4 * i + 1] = __builtin_amdgcn_exp2f(s[4 * i + 1] + s1); s[4 * i + 0] = __builtin_amdgcn_exp2f(s[4 * i + 0] + s0); }
                carry += tot;
#if SB_EARLY_EXIT
                if (__all(carry < SB_EXIT_LOG2)) done = true;
#endif
            } else {
                const float t0 = slope2 * (float)(32 * del);
#pragma unroll
                for (int q = 0; q < 16; ++q) s[q] = __builtin_fmaf(s[q], C2Q, nb[q]) - t0;
                if (del == 0) {
#pragma unroll
                    for (int q = 0; q < 16; ++q) if (crow(q, hi) > r32) s[q] = -INFINITY;
                } else if (del == 4) {
#pragma unroll
                    for (int q = 0; q < 16; ++q) if (crow(q, hi) < r32) s[q] = -INFINITY;
                }
                float rm = __builtin_fmaxf(s[0], s[1]);
#pragma unroll
                for (int q = 2; q < 16; ++q) rm = __builtin_fmaxf(rm, s[q]);
                float r_lo, r_hi; swap32(rm, r_lo, r_hi);
                const float mn = __builtin_fmaxf(m, __builtin_fmaxf(r_lo, r_hi));
                float ps = 0.f;
#pragma unroll
                for (int q = 0; q < 16; ++q) { s[q] = __builtin_amdgcn_exp2f(s[q] - mn); ps += s[q]; }
                if (__all(mn == m)) lsum += ps;
                else { const float alpha = __builtin_amdgcn_exp2f(m - mn); lsum = lsum * alpha + ps; m = mn;
#pragma unroll
                    for (int c = 0; c < 4; ++c)
#pragma unroll
                        for (int q = 0; q < 16; ++q) o[c][q] *= alpha; }
            }
            pv_tile(o, s, st + 8192, tro);
        }
        if (SB) { const unsigned fa = (unsigned)(uintptr_t)(flags + 8 * (j & 1) + wave), fv = (done || tau == 0) ? 1u : 0u;
            asm volatile("ds_write_b32 %0, %1" :: "v"(fa), "v"(fv) : "memory"); }
    }
    asm volatile("s_waitcnt vmcnt(0) lgkmcnt(0)" ::: "memory");
#undef ISSUE
    const size_t tok = (size_t)b * SEQ + rho_w + (size_t)r * (32 * qblk_w + r32);
    if (SB) {
        float ss = 0.f;
#pragma unroll
        for (int c = 0; c < 4; ++c)
#pragma unroll
            for (int q = 0; q < 16; ++q) ss += o[c][q] * o[c][q];
        float s_lo, s_hi; swap32(ss, s_lo, s_hi);
        const float rstd = 1.0f / sqrtf((s_lo + s_hi) * (1.f / HD) + EPS);
        const bf16* Zs = P.proj + T_SBZ * PROJ_STRIDE + hb + (size_t)(32 * qblk_w + r32) * HD; bf16* Yr = P.Y + tok * MIXW + h * HD;
        v2u zw[16]; f32x4 gg[16];
#pragma unroll
        for (int c = 0; c < 4; ++c)
#pragma unroll
            for (int i = 0; i < 4; ++i) { const int d0 = 32 * c + 8 * i + 4 * hi; zw[4 * c + i] = *(const v2u*)(Zs + d0); gg[4 * c + i] = *(const f32x4*)(P.g_sb + h * HD + d0); }
#pragma unroll
        for (int c = 0; c < 4; ++c)
#pragma unroll
            for (int i = 0; i < 4; ++i) { const int d0 = 32 * c + 8 * i + 4 * hi; const v2u z = zw[4 * c + i]; const f32x4 g = gg[4 * c + i];
                const float y0 = o[c][4 * i] * rstd * g.x * silu_f(bflo(z.x)), y1 = o[c][4 * i + 1] * rstd * g.y * silu_f(bfhi(z.x));
                const float y2 = o[c][4 * i + 2] * rstd * g.z * silu_f(bflo(z.y)), y3 = o[c][4 * i + 3] * rstd * g.w * silu_f(bfhi(z.y));
                v2u w; w.x = cvtpk_s(y0, y1); w.y = cvtpk_s(y2, y3); *(v2u*)(Yr + d0) = w; }
    } else {
        float l_lo, l_hi; swap32(lsum, l_lo, l_hi);
        const float lt = l_lo + l_hi, inv = 1.0f / lt;
        bf16* Or = P.opart + (size_t)p * PROJ_STRIDE + tok * GW + h * HD;
#pragma unroll
        for (int c = 0; c < 4; ++c)
#pragma unroll
            for (int i = 0; i < 4; ++i) { const int d0 = 32 * c + 8 * i + 4 * hi;
                v2u w; w.x = cvtpk_s(o[c][4 * i] * inv, o[c][4 * i + 1] * inv); w.y = cvtpk_s(o[c][4 * i + 2] * inv, o[c][4 * i + 3] * inv); *(v2u*)(Or + d0) = w; }
        if (hi == 0) P.lpart[(size_t)p * (MTOK * NH) + tok * NH + h] = m + __builtin_amdgcn_logf(lt);
    }
    asm volatile("s_waitcnt vmcnt(0)" ::: "memory");
    ATT_BAR();
}


#define XB_TMO      128
#define XB_XCNT(j)  (256  + 64 * (j))
#define XB_XSUB(j)  (1280 + 64 * (j))
#define XB_XGEN(j)  (2304 + 64 * (j))
#define XB_TOP      3328
#define XB_TOPGEN   3392
#define XCD_BAR_WORDS 3456
#define XB_SPIN_CAP (1u << 18)
__device__ __forceinline__ unsigned xb_ld(unsigned* p)              { return __hip_atomic_load(p, __ATOMIC_RELAXED, __HIP_MEMORY_SCOPE_AGENT); }
__device__ __forceinline__ unsigned xb_add(unsigned* p, unsigned v) { return __hip_atomic_fetch_add(p, v, __ATOMIC_RELAXED, __HIP_MEMORY_SCOPE_AGENT); }
__device__ __forceinline__ unsigned xb_xcc_id() { return (unsigned)__builtin_amdgcn_s_getreg((3 << 11) | 20) & 0xFu; }
#define XB_SPIN(cond, bar) do { unsigned _sp = 0; while (cond) { __builtin_amdgcn_s_sleep(1); \
    if ((++_sp & 255u) == 0u) { if (xb_ld(&(bar)[XB_TMO])) break; if (_sp > XB_SPIN_CAP) { atomicAdd(&(bar)[XB_TMO], 1u); break; } } } } while (0)
struct XcdBarrier { unsigned* bar; unsigned x; volatile LAS unsigned* st; };
__device__ __forceinline__ XcdBarrier xcd_barrier_post(unsigned* bar, volatile LAS unsigned* st) {
    XcdBarrier b; b.bar = bar; b.x = xb_xcc_id(); b.st = st;
    if (threadIdx.x == 0) (void)xb_add(&bar[XB_XCNT(b.x)], 1u);
    return b;
}
__device__ __forceinline__ void xcd_barrier_complete(unsigned* bar, unsigned x, unsigned& nloc, unsigned& nx) {
    const unsigned G = gridDim.x * gridDim.y * gridDim.z;
    unsigned sum, cnt, mine, sp = 0u;
    for (;;) {
        sum = 0u; cnt = 0u; mine = 0u;
#pragma unroll
        for (unsigned j = 0; j < 16; ++j) { const unsigned c = xb_ld(&bar[XB_XCNT(j)]); sum += c; cnt += (c > 0u) ? 1u : 0u; mine = (j == x) ? c : mine; }
        if (sum == G) break;
        __builtin_amdgcn_s_sleep(1);
        if ((++sp & 255u) == 0u) { if (xb_ld(&bar[XB_TMO])) break; if (sp > XB_SPIN_CAP) { atomicAdd(&bar[XB_TMO], 1u); break; } }
    }
    nloc = mine > 0u ? mine : 1u; nx = cnt > 0u ? cnt : 1u;
}
__device__ __forceinline__ void xcd_barrier(const XcdBarrier& b) {
    asm volatile("s_waitcnt vmcnt(0)" ::: "memory");
    __syncthreads();
    if (threadIdx.x == 0) {
        unsigned* bar = b.bar;
        __builtin_amdgcn_s_waitcnt(0);
        unsigned nloc = b.st[0], nx = b.st[1];
        if (nloc == 0u) { xcd_barrier_complete(bar, b.x, nloc, nx); b.st[0] = nloc; b.st[1] = nx; }
        const unsigned old = xb_add(&bar[XB_XSUB(b.x)], 1u);
        const unsigned gen = old / nloc;
        if (old + 1u == (gen + 1u) * nloc) {
            __builtin_amdgcn_fence(__ATOMIC_RELEASE, "agent");
            asm volatile("s_waitcnt vmcnt(0)" ::: "memory");
            const unsigned og = xb_add(&bar[XB_TOP], 1u);
            const unsigned tg = og / nx;
            if (og + 1u == (tg + 1u) * nx) xb_add(&bar[XB_TOPGEN], 1u);
            else XB_SPIN(xb_ld(&bar[XB_TOPGEN]) == tg, bar);
            __builtin_amdgcn_fence(__ATOMIC_ACQUIRE, "agent");
            xb_add(&bar[XB_XGEN(b.x)], 1u);
            asm volatile("s_waitcnt vmcnt(0)" ::: "memory");
        } else {
            XB_SPIN(xb_ld(&bar[XB_XGEN(b.x)]) == gen, bar);
            __builtin_amdgcn_fence(__ATOMIC_ACQUIRE, "agent");
            asm volatile("s_waitcnt vmcnt(0)" ::: "memory");
        }
    }
    __syncthreads();
}

struct Args { const float* x; const float* c; const float* w_ada; const float* b_ada; const float* g_norm; const float* w_in; const float* g_sb; const float* g_dil; const float* w_out; const float* g_final;
              float* out; unsigned char* ws; int ph_lo, ph_hi; };

__global__ void __launch_bounds__(NTHREADS) hybrid_fwd(Args args) {
    extern __shared__ __attribute__((aligned(16))) unsigned char lds_raw[];
    LAS unsigned char* lds = (LAS unsigned char*)lds_raw;
    const int tid = threadIdx.x, lane = tid & 63, wave = __builtin_amdgcn_readfirstlane(tid >> 6);
    const int G = gridDim.x, gw = blockIdx.x * NWAVES + wave, NGW = G * NWAVES;
    const int vcu = (G % 8 == 0) ? ((int)blockIdx.x % 8) * (G / 8) + (int)blockIdx.x / 8 : (int)blockIdx.x, vgw = vcu * NWAVES + wave;
    unsigned char* ws = args.ws;
    unsigned* ctl = (unsigned*)(ws + WS_CTL);
    float* modacc = (float*)(ws + WS_CTL + CTL_MOD_OFF);
    bf16* WtIn = (bf16*)(ws + WS_WTIN); bf16* WtOut = (bf16*)(ws + WS_WTOUT); bf16* Hb = (bf16*)(ws + WS_H); bf16* Proj = (bf16*)(ws + WS_PROJ);
    bf16* Yb = (bf16*)(ws + WS_Y); bf16* Opart = (bf16*)(ws + WS_OPART); float* Lpart = (float*)(ws + WS_LPART);
    const int lo = args.ph_lo, hi = args.ph_hi;
#ifndef PH_MASK
#define PH_MASK 0x7f
#endif
#define IN(k) (((PH_MASK >> (k)) & 1) && lo <= (k) && (k) < hi)
#if USE_CG_SYNC
#define SEAM(k) do { if (IN(k) && IN((k) + 1)) cg::this_grid().sync(); } while (0)
#define SEAM_ALWAYS() cg::this_grid().sync()
#else
    if (lo < 0) cg::this_grid().sync();
    volatile LAS unsigned* MISC = (volatile LAS unsigned*)(lds + LDS_MISC_OFF);
    if (tid < 16) MISC[tid] = 0u;
    __syncthreads();
    const XcdBarrier xbar = xcd_barrier_post(ctl + CTL_BAR_OFF / 4, MISC + 8);
#define SEAM(k) do { if (IN(k) && IN((k) + 1)) xcd_barrier(xbar); } while (0)
#define SEAM_ALWAYS() xcd_barrier(xbar)
#endif

    if (REP_MASK & 128) { for (int i = 0; i < 10; ++i) SEAM_ALWAYS(); }
    if (IN(0)) {
        LAS float* scr = (LAS float*)(lds + wave * 16384);
        constexpr int I_IN = (DM / 64) * (INC / 32), I_OUT = (MIXW / 64) * (DM / 32), I_MOD = (DM / 128) * 48;
        if (REP_MASK & 1) for (int it = gw; it < I_IN + I_OUT; it += NGW) { if (it < I_IN) p0_transpose_item(args.w_in, DM, INC, WtIn, scr, it, lane); else p0_transpose_item(args.w_out, MIXW, DM, WtOut, scr, it - I_IN, lane); }
        unsigned* modcnt = ctl + 128;
        for (int it = gw; it < I_MOD + I_IN + I_OUT; it += NGW) {
            int r = it;
            if (r < I_MOD) { p0_mod_item(args.c, args.w_ada, modacc, scr, r, lane);
                if (REP_MASK & 256) p0_mod_item(args.c, args.w_ada, modacc + 4 * 12288, scr, r, lane);
                asm volatile("s_waitcnt vmcnt(0)" ::: "memory");
                if (lane == 0) __hip_atomic_fetch_add(modcnt, 1u, __ATOMIC_RELAXED, __HIP_MEMORY_SCOPE_AGENT);
                continue; } r -= I_MOD;
            if (r < I_IN) { p0_transpose_item(args.w_in, DM, INC, WtIn, scr, r, lane); continue; } r -= I_IN;
            p0_transpose_item(args.w_out, MIXW, DM, WtOut, scr, r, lane);
        }
        if (IN(1)) { unsigned sp = 0; while (__hip_atomic_load(modcnt, __ATOMIC_RELAXED, __HIP_MEMORY_SCOPE_AGENT) < (unsigned)I_MOD) { __builtin_amdgcn_s_sleep(2); if (++sp > (1u << 22)) break; }
            __builtin_amdgcn_fence(__ATOMIC_ACQUIRE, "agent"); }
    }
    if (!(IN(0) && IN(1))) SEAM(0);
    if (IN(1)) {
#pragma nounroll
        for (int m = gw; m < MTOK; m += NGW) p1_row(args.x + (size_t)m * DM, args.g_norm, modacc + (size_t)(m >> 11) * 12288, args.b_ada, Hb + (size_t)m * DM, lane);
    }
    SEAM(1);
    if (IN(2)) {
        pg8::Gemm g{Hb, WtIn, MTOK, INC, DM}; pg8::StaticOrder S; S.init(MTOK, INC, G, (int)blockIdx.x);
        pg8::EpiBf16 E{Proj, PROJ_STRIDE};
        pg8::gemm_phase<pg8::EpiBf16, pg8::StaticOrder, GEMM1_ALIGN_EPI, true>(lds, g, S, E);
        if (REP_MASK & 4) pg8::gemm_phase<pg8::EpiBf16, pg8::StaticOrder, GEMM1_ALIGN_EPI, true>(lds, g, S, E);
    }
    SEAM(2);
    if (IN(3)) {
        const AttnP P{Proj, Yb, Opart, Lpart, args.g_sb};
        if (ATT_DYNAMIC && G == 256 && !(REP_MASK & (8 | 512 | 1024))) {
            const int vx = vcu >> 5; unsigned* head = ctl + 256 + 64 * vx;
            volatile LAS unsigned* tick = (volatile LAS unsigned*)(lds + LDS_MISC_OFF) + 4;
            unsigned mine = 0;
            if (tid == 0) mine = __hip_atomic_fetch_add(head, 1u, __ATOMIC_RELAXED, __HIP_MEMORY_SCOPE_AGENT);
            for (;;) {
                if (tid == 0) *tick = mine;
                ATT_BAR();
                const unsigned t = *tick;
                if (t >= 256u) break;
                if (tid == 0) mine = __hip_atomic_fetch_add(head, 1u, __ATOMIC_RELAXED, __HIP_MEMORY_SCOPE_AGENT);
                const int kind = (int)(t >> 6), uid = 64 * vx + (int)(t & 63);
                if (kind == 0) attn_unit<true>(P, 0, uid, lds, wave, lane);
                else attn_unit<false>(P, kind - 1, uid, lds, wave, lane);
            }
        } else {
        for (int rep = 0; rep < ((REP_MASK & (8 | 512 | 1024)) ? 2 : 1); ++rep)
        for (int u = vcu, rnd = 0; u < 2048; u += G, ++rnd) {
            const int kind = u >> 9; int uid = u & 511;
            if (rnd & 1) uid ^= (kind <= 1) ? 15 : (kind == 2) ? 3 : 0;
            if (rep == 1 && (REP_MASK & 512) && kind != 0) continue;
            if (rep == 1 && (REP_MASK & 1024) && kind == 0) continue;
            if (kind == 0) attn_unit<true>(P, 0, uid, lds, wave, lane);
            else attn_unit<false>(P, kind - 1, uid, lds, wave, lane);
        }
        }
    }
    SEAM(3);
    if (IN(4)) {
        const bf16* Zs = Proj + T_DLZ * PROJ_STRIDE;
        const int hcol = tid & 255, h = hcol >> 4, col = hcol * 8;
        const f32x4 g0 = *(const f32x4*)(args.g_dil + col), g1 = *(const f32x4*)(args.g_dil + col + 4);
        const size_t tstep = (size_t)2 * G;
#pragma nounroll
        for (size_t tok0 = (size_t)blockIdx.x * 2 + (tid >> 8); tok0 < (size_t)MTOK; tok0 += 4 * tstep) {
            float L[4][3]; v4u o0[4], o1[4], o2[4], zw[4];
#pragma unroll
            for (int k = 0; k < 4; ++k) { const size_t tok = tok0 + k * tstep; const bool ok = tok < (size_t)MTOK; const size_t tk = ok ? tok : tok0;
                L[k][0] = Lpart[tk * NH + h]; L[k][1] = Lpart[(size_t)MTOK * NH + tk * NH + h]; L[k][2] = Lpart[(size_t)2 * MTOK * NH + tk * NH + h];
                o0[k] = *(const v4u*)(Opart + tk * GW + col); o1[k] = *(const v4u*)(Opart + PROJ_STRIDE + tk * GW + col); o2[k] = *(const v4u*)(Opart + 2 * PROJ_STRIDE + tk * GW + col);
                zw[k] = *(const v4u*)(Zs + (((tk >> 11) * NH + h) * SEQ + (tk & 2047)) * HD + (col & 127)); }
#pragma unroll
            for (int k = 0; k < 4; ++k) { const size_t tok = tok0 + k * tstep;
                const float mx = __builtin_fmaxf(L[k][0], __builtin_fmaxf(L[k][1], L[k][2]));
                float w0 = __builtin_amdgcn_exp2f(L[k][0] - mx), w1 = __builtin_amdgcn_exp2f(L[k][1] - mx), w2 = __builtin_amdgcn_exp2f(L[k][2] - mx);
                const float inv = 1.0f / (w0 + w1 + w2); w0 *= inv; w1 *= inv; w2 *= inv;
                float y[8]; float ss = 0.f;
#pragma unroll
                for (int e = 0; e < 4; ++e) { y[2 * e] = w0 * bflo(o0[k][e]) + w1 * bflo(o1[k][e]) + w2 * bflo(o2[k][e]); y[2 * e + 1] = w0 * bfhi(o0[k][e]) + w1 * bfhi(o1[k][e]) + w2 * bfhi(o2[k][e]);
                    ss += y[2 * e] * y[2 * e] + y[2 * e + 1] * y[2 * e + 1]; }
                ss += __shfl_xor(ss, 1); ss += __shfl_xor(ss, 2); ss += __shfl_xor(ss, 4); ss += __shfl_xor(ss, 8);
                const float rstd = 1.0f / sqrtf(ss * (1.f / HD) + EPS);
                v4u w;
                w.x = cvtpk_s(y[0] * rstd * g0.x * silu_f(bflo(zw[k].x)), y[1] * rstd * g0.y * silu_f(bfhi(zw[k].x)));
                w.y = cvtpk_s(y[2] * rstd * g0.z * silu_f(bflo(zw[k].y)), y[3] * rstd * g0.w * silu_f(bfhi(zw[k].y)));
                w.z = cvtpk_s(y[4] * rstd * g1.x * silu_f(bflo(zw[k].z)), y[5] * rstd * g1.y * silu_f(bfhi(zw[k].z)));
                w.w = cvtpk_s(y[6] * rstd * g1.z * silu_f(bflo(zw[k].w)), y[7] * rstd * g1.w * silu_f(bfhi(zw[k].w)));
                if (tok < (size_t)MTOK) *(v4u*)(Yb + tok * MIXW + GW + col) = w; }
        }
    }
    SEAM(4);
    const bool fuse_final = (FUSE_FINAL != 0) && G == 256 && IN(5) && IN(6);
    if (IN(5)) {
        pg8::Gemm g{Yb, WtOut, MTOK, DM, MIXW};
        if (fuse_final) {
            pg8::PanelOrder S{(int)blockIdx.x};
            pg8::EpiFinal E{args.x, args.out, modacc, args.b_ada, args.g_final, (float*)(ws + WS_CTL + CTL_SS_OFF), (unsigned*)(ws + WS_CTL + CTL_PCNT_OFF), DM};
            pg8::gemm_phase<pg8::EpiFinal, pg8::PanelOrder, true, true>(lds, g, S, E);
        } else {
            pg8::StaticOrder S; S.init(MTOK, DM, G, (int)blockIdx.x);
            pg8::EpiResGate E{args.x, args.out, modacc, args.b_ada, DM};
            pg8::gemm_phase<pg8::EpiResGate, pg8::StaticOrder, true, true>(lds, g, S, E);
            if (REP_MASK & 32) pg8::gemm_phase<pg8::EpiResGate, pg8::StaticOrder, true, true>(lds, g, S, E);
        }
    }
    if (!fuse_final) SEAM(5);
    if (IN(6) && !fuse_final) {
#pragma nounroll
        for (int m = gw; m < MTOK; m += NGW) {
            f32x4* xr = (f32x4*)(args.out + (size_t)m * DM) + lane;
            f32x4 v[16]; float s = 0.f;
#pragma unroll
            for (int j = 0; j < 16; ++j) { v[j] = xr[64 * j]; s += (v[j].x * v[j].x + v[j].y * v[j].y) + (v[j].z * v[j].z + v[j].w * v[j].w); }
            const float rstd = 1.0f / sqrtf(wave_sum(s) * (1.f / DM) + EPS);
#pragma unroll
            for (int j = 0; j < 16; ++j) { const f32x4 gg = *(const f32x4*)(args.g_final + 4 * (64 * j + lane)); xr[64 * j] = v[j] * rstd * gg; }
        }
    }
#undef IN
#undef SEAM
}

extern "C" void kernel_launch(void* const* d_in, const int* in_sizes, int n_in, void* d_out, int out_size, void* d_ws, size_t ws_size, hipStream_t stream) {
    static int grid = 0;
    if (grid == 0) {
        if (n_in != 10 || in_sizes[0] != MTOK * DM || out_size != MTOK * DM || ws_size < WS_END) { fprintf(stderr, "kernel_launch: unexpected shapes / workspace (n_in %d, ws %zu)\n", n_in, ws_size); grid = -1; return; }
        int dev = 0, cus = 0, per_cu = 0;
        if (hipGetDevice(&dev) != hipSuccess || hipDeviceGetAttribute(&cus, hipDeviceAttributeMultiprocessorCount, dev) != hipSuccess) { grid = -1; return; }
        if (hipFuncSetAttribute((const void*)hybrid_fwd, hipFuncAttributeMaxDynamicSharedMemorySize, LDS_BYTES) != hipSuccess) { fprintf(stderr, "kernel_launch: hipFuncSetAttribute failed\n"); grid = -1; return; }
        if (hipOccupancyMaxActiveBlocksPerMultiprocessor(&per_cu, (const void*)hybrid_fwd, NTHREADS, LDS_BYTES) != hipSuccess || per_cu < 1) { fprintf(stderr, "kernel_launch: occupancy query says %d\n", per_cu); per_cu = 1; }
        (void)hipGetLastError();
        grid = cus;
    }
    if (grid < 0) return;
    (void)hipMemsetAsync((char*)d_ws + WS_CTL, 0, CTL_ZERO_BYTES, stream);
    Args a{};
    a.x = (const float*)d_in[0]; a.c = (const float*)d_in[1]; a.w_ada = (const float*)d_in[2]; a.b_ada = (const float*)d_in[3]; a.g_norm = (const float*)d_in[4];
    a.w_in = (const float*)d_in[5]; a.g_sb = (const float*)d_in[6]; a.g_dil = (const float*)d_in[7]; a.w_out = (const float*)d_in[8]; a.g_final = (const float*)d_in[9];
    a.out = (float*)d_out; a.ws = (unsigned char*)d_ws;
#if MK_N_LAUNCHES == 1
    a.ph_lo = 0; a.ph_hi = 7;
    void* kargs[] = {&a};
    hipError_t e = hipLaunchCooperativeKernel((const void*)hybrid_fwd, dim3(grid), dim3(NTHREADS), kargs, LDS_BYTES, stream);
    if (e != hipSuccess) fprintf(stderr, "kernel_launch: cooperative launch failed: %s (grid %d)\n", hipGetErrorString(e), grid);
#else
    for (int ph = 0; ph < 7; ++ph) { a.ph_lo = ph; a.ph_hi = ph + 1; hipLaunchKernelGGL(hybrid_fwd, dim3(grid), dim3(NTHREADS), LDS_BYTES, stream, a); }
#endif
}
```
